# Optimizing an MI355X kernel written in HIP

```python
import math
import jax
import jax.numpy as jnp
from jax import lax
import numpy as np

D_MODEL = 1024
BATCH = 2
SEQ = 8192
DEPTH = 2

MIX_W = D_MODEL
GROUP_W = MIX_W // 2
N_EVEN = (DEPTH + 1) // 2
N_ODD = DEPTH // 2
RMS_EPS = 1e-6
D_FF = 2816

HG_HEADS = 4
HG_DK = GROUP_W // HG_HEADS
HG_DV = GROUP_W // HG_HEADS
HG_CHUNK = 32
SC_CH = GROUP_W
CONV_W = 3
ML_HEADS = 4
ML_DH = GROUP_W // ML_HEADS
ML_CHUNK = 64
MB_HEADS = 4
MB_DH = GROUP_W // MB_HEADS
MB_BLOCK = 256
MB_TOPK = 3
MB_QCHUNK = 64
ROPE_THETA = 500000.0
ROPE_DIM = MB_DH // 4

AB_IN = 4 * GROUP_W + 3 * SC_CH
CD_IN = 4 * GROUP_W + 2 * ML_HEADS + 3 * GROUP_W

kernel_name = "hybrid_hgrn2_shortconv_mlstm_moba_macaron"


def rms_norm(x, gain):
    xf = x.astype(jnp.float32)
    y = xf * lax.rsqrt(jnp.mean(xf * xf, axis=-1, keepdims=True) + RMS_EPS)
    return (y * gain.astype(jnp.float32)).astype(x.dtype)


def swiglu(x, w_in, w_out):
    gate, up = jnp.split(x @ w_in, 2, axis=-1)
    return (jax.nn.silu(gate) * up) @ w_out


def split_heads(t, n_heads):
    return t.reshape(t.shape[0], t.shape[1], n_heads, -1)


def to_chunks(t, chunk):
    b, s = t.shape[0], t.shape[1]
    return jnp.moveaxis(t.reshape(b, s // chunk, chunk, *t.shape[2:]), 3, 1)


def from_chunks(t):
    b, h, nc, l, d = t.shape
    return jnp.moveaxis(t, 1, 3).reshape(b, nc * l, h, d)


def hgrn2_heads(q, f_pre, i_in, lb):
    f = lb + (1.0 - lb) * jax.nn.sigmoid(f_pre)
    qc = to_chunks(jax.nn.silu(q), HG_CHUNK)
    kc = to_chunks(1.0 - f, HG_CHUNK)
    vc = to_chunks(i_in, HG_CHUNK)
    b = jnp.cumsum(to_chunks(jnp.log(f), HG_CHUNK), axis=3)
    b_end = b[:, :, :, -1:, :]
    q_dec = qc * jnp.exp(b)
    k_dec = kc * jnp.exp(-b)
    causal = jnp.tril(jnp.ones((HG_CHUNK, HG_CHUNK), dtype=bool))
    attn = jnp.where(causal, jnp.einsum('bhcid,bhcjd->bhcij', q_dec, k_dec), 0.0)
    o_intra = jnp.einsum('bhcij,bhcjv->bhciv', attn, vc)
    d_state = jnp.einsum('bhcjd,bhcjv->bhcdv', kc * jnp.exp(b_end - b), vc)
    decay = jnp.exp(b_end[:, :, :, 0, :])

    def step(state, xs):
        dec, ds = xs
        return dec[..., None] * state + ds, state

    s0 = jnp.zeros(d_state.shape[:2] + d_state.shape[3:], d_state.dtype)
    _, s_prev = lax.scan(step, s0, (jnp.moveaxis(decay, 2, 0), jnp.moveaxis(d_state, 2, 0)))
    s_prev = jnp.moveaxis(s_prev, 0, 2)
    o = o_intra + jnp.einsum('bhcid,bhcdv->bhciv', q_dec, s_prev)
    return from_chunks(o)


def short_conv_channels(b_gate, c_gate, u, conv_w, conv_b):
    z = c_gate * u
    s = z.shape[1]
    zp = jnp.pad(z, ((0, 0), (CONV_W - 1, 0), (0, 0)))
    y = conv_b + sum(conv_w[j] * zp[:, j:j + s] for j in range(CONV_W))
    return b_gate * y


def mlstm_heads(q, k, v, log_i, log_f):
    qc, kc, vc = (to_chunks(t, ML_CHUNK) for t in (q, k, v))
    ic = to_chunks(log_i, ML_CHUNK)
    b = jnp.cumsum(to_chunks(log_f, ML_CHUNK), axis=-1)
    b_end = b[..., -1]
    causal = jnp.tril(jnp.ones((ML_CHUNK, ML_CHUNK), dtype=bool))
    d_log = jnp.where(causal, b[..., :, None] - b[..., None, :] + ic[..., None, :], -jnp.inf)
    w_end = b_end[..., None] - b + ic
    m_end = jnp.max(w_end, axis=-1)

    def step(carry, xs):
        c_mat, n_vec, m = carry
        k_c, v_c, w_c, m_c, be = xs
        m_new = jnp.maximum(be + m, m_c)
        a = jnp.exp(be + m - m_new)
        wk = jnp.exp(w_c - m_new[..., None])[..., None] * k_c
        c_new = a[..., None, None] * c_mat + jnp.einsum('bhld,bhle->bhde', wk, v_c)
        n_new = a[..., None] * n_vec + wk.sum(axis=-2)
        return (c_new, n_new, m_new), (c_mat, n_vec, m)

    bsz, n_h, dh = q.shape[0], q.shape[2], q.shape[3]
    init = (jnp.zeros((bsz, n_h, dh, dh), q.dtype), jnp.zeros((bsz, n_h, dh), q.dtype),
            jnp.zeros((bsz, n_h), q.dtype))
    xs = tuple(jnp.moveaxis(t, 2, 0) for t in (kc, vc, w_end, m_end, b_end))
    _, (c_prev, n_prev, m_prev) = lax.scan(step, init, xs)
    c_prev = jnp.moveaxis(c_prev, 0, 2)
    n_prev = jnp.moveaxis(n_prev, 0, 2)
    m_prev = jnp.moveaxis(m_prev, 0, 2)
    log_inter = b + m_prev[..., None]
    m_t = jnp.maximum(log_inter, jnp.max(d_log, axis=-1))
    weights = jnp.exp(d_log - m_t[..., None]) * jnp.einsum('bhcid,bhcjd->bhcij', qc, kc)
    a_in = jnp.exp(log_inter - m_t)
    num = jnp.einsum('bhcij,bhcje->bhcie', weights, vc) + a_in[..., None] * jnp.einsum('bhcid,bhcde->bhcie', qc, c_prev)
    den = weights.sum(axis=-1) + a_in * jnp.einsum('bhcid,bhcd->bhci', qc, n_prev)
    h = num / jnp.maximum(jnp.abs(den), jnp.exp(-m_t))[..., None]
    return from_chunks(h)


def rope_partial(x, pos):
    half = ROPE_DIM // 2
    inv_freq = jnp.float32(ROPE_THETA) ** (-jnp.arange(half, dtype=jnp.float32) * 2.0 / ROPE_DIM)
    ang = pos.astype(jnp.float32)[:, None] * inv_freq[None, :]
    cos = jnp.cos(ang)[None, :, None, :]
    sin = jnp.sin(ang)[None, :, None, :]
    x1, x2, x_pass = x[..., :half], x[..., half:ROPE_DIM], x[..., ROPE_DIM:]
    return jnp.concatenate([x1 * cos - x2 * sin, x2 * cos + x1 * sin, x_pass], axis=-1)


def moba_heads(q, k, v):
    bsz, s, n_h, dh = q.shape
    s_pad = -(-s // MB_BLOCK) * MB_BLOCK
    n_blk = s_pad // MB_BLOCK
    n_sel = min(MB_TOPK, n_blk)
    padw = ((0, 0), (0, s_pad - s), (0, 0), (0, 0))
    q, k, v = (jnp.pad(t, padw).transpose(0, 2, 1, 3) for t in (q, k, v))
    k_blk = k.reshape(bsz, n_h, n_blk, MB_BLOCK, dh)
    v_blk = v.reshape(bsz, n_h, n_blk, MB_BLOCK, dh)
    k_mean = k_blk.mean(axis=3)
    n_qc = s_pad // MB_QCHUNK
    q_chunks = jnp.moveaxis(q.reshape(bsz, n_h, n_qc, MB_QCHUNK, dh), 2, 0)
    b_idx = jnp.arange(bsz)[:, None, None, None]
    h_idx = jnp.arange(n_h)[None, :, None, None]
    blk_ids = jnp.arange(n_blk)

    def attend(args):
        c, q_c = args
        q_pos = c * MB_QCHUNK + jnp.arange(MB_QCHUNK)
        own = (c * MB_QCHUNK) // MB_BLOCK
        gate = jnp.einsum('bhqd,bhnd->bhqn', q_c, k_mean)
        gate = jnp.where(blk_ids < own, gate, -jnp.inf)
        g_val, sel = lax.top_k(gate, n_sel)
        sel_ok = jnp.isfinite(g_val)
        k_sel = k_blk[b_idx, h_idx, sel]
        v_sel = v_blk[b_idx, h_idx, sel]
        s_past = jnp.einsum('bhqd,bhqnld->bhqnl', q_c, k_sel)
        s_past = jnp.where(sel_ok[..., None], s_past, -jnp.inf).reshape(bsz, n_h, MB_QCHUNK, n_sel * MB_BLOCK)
        k_own = lax.dynamic_index_in_dim(k_blk, own, axis=2, keepdims=False)
        v_own = lax.dynamic_index_in_dim(v_blk, own, axis=2, keepdims=False)
        k_pos = own * MB_BLOCK + jnp.arange(MB_BLOCK)
        s_own = jnp.where(k_pos[None, :] <= q_pos[:, None], jnp.einsum('bhqd,bhld->bhql', q_c, k_own), -jnp.inf)
        p = jax.nn.softmax(jnp.concatenate([s_past, s_own], axis=-1), axis=-1)
        p_past = p[..., :n_sel * MB_BLOCK].reshape(bsz, n_h, MB_QCHUNK, n_sel, MB_BLOCK)
        p_own = p[..., n_sel * MB_BLOCK:]
        return jnp.einsum('bhqnl,bhqnld->bhqd', p_past, v_sel) + jnp.einsum('bhql,bhld->bhqd', p_own, v_own)

    out = lax.map(attend, (jnp.arange(n_qc), q_chunks))
    out = jnp.moveaxis(out, 0, 2).reshape(bsz, n_h, s_pad, dh)[:, :, :s]
    return out.transpose(0, 2, 1, 3)


def mixer_ab(h, w_in, w_out, lb, hg_norm, conv_w, conv_b):
    proj = (h @ w_in).astype(jnp.float32)
    q, f_pre, i_in, g, sc_b, sc_c, sc_u = jnp.split(proj, 7, axis=-1)
    o = hgrn2_heads(split_heads(q, HG_HEADS), split_heads(f_pre, HG_HEADS),
                    split_heads(i_in, HG_HEADS), lb.reshape(HG_HEADS, HG_DK))
    o = rms_norm(o, hg_norm) * jax.nn.silu(split_heads(g, HG_HEADS))
    y_hg = o.reshape(h.shape[0], h.shape[1], GROUP_W)
    y_sc = short_conv_channels(sc_b, sc_c, sc_u, conv_w, conv_b)
    return jnp.concatenate([y_hg, y_sc], axis=-1).astype(h.dtype) @ w_out


def mixer_cd(h, w_in, w_out, gate_bias, ml_norm):
    bsz, s = h.shape[0], h.shape[1]
    proj = (h @ w_in).astype(jnp.float32)
    ml_q, ml_k, ml_v, ml_o = jnp.split(proj[..., :4 * GROUP_W], 4, axis=-1)
    gates = proj[..., 4 * GROUP_W:4 * GROUP_W + 2 * ML_HEADS]
    mb_q, mb_k, mb_v = jnp.split(proj[..., 4 * GROUP_W + 2 * ML_HEADS:], 3, axis=-1)
    log_i = gates[..., :ML_HEADS] + gate_bias[0]
    log_f = jax.nn.log_sigmoid(gates[..., ML_HEADS:] + gate_bias[1])
    h_ml = mlstm_heads(split_heads(ml_q, ML_HEADS) * ML_DH ** -0.5, split_heads(ml_k, ML_HEADS),
                       split_heads(ml_v, ML_HEADS), log_i, log_f)
    h_ml = rms_norm(h_ml, ml_norm) * jax.nn.sigmoid(split_heads(ml_o, ML_HEADS))
    pos = jnp.arange(s)
    y_mb = moba_heads(rope_partial(split_heads(mb_q, MB_HEADS), pos) * MB_DH ** -0.5,
                      rope_partial(split_heads(mb_k, MB_HEADS), pos), split_heads(mb_v, MB_HEADS))
    y = jnp.concatenate([h_ml.reshape(bsz, s, GROUP_W), y_mb.reshape(bsz, s, GROUP_W)], axis=-1)
    return y.astype(h.dtype) @ w_out


def setup_inputs(seed: int = 0) -> dict:
    key = jax.random.key(seed)
    ks = jax.random.split(key, 17)

    def dense(k, shape, fan_in):
        return jax.random.normal(k, shape, jnp.float32) * fan_in ** -0.5

    def gain(k, shape):
        return 1.0 + 0.02 * jax.random.normal(k, shape, jnp.float32)

    gate_bias = jnp.stack([0.1 * jax.random.normal(ks[13], (N_ODD, ML_HEADS), jnp.float32),
                           jnp.linspace(3.0, 6.0, ML_HEADS, dtype=jnp.float32)[None, :]
                           + 0.1 * jax.random.normal(ks[14], (N_ODD, ML_HEADS), jnp.float32)], axis=1)
    return {
        "x": jax.random.normal(ks[0], (BATCH, SEQ, D_MODEL), jnp.float32),
        "ffn_norm": gain(ks[1], (DEPTH, 2, D_MODEL)),
        "ffn_w_in": dense(ks[2], (DEPTH, 2, D_MODEL, 2 * D_FF), D_MODEL),
        "ffn_w_out": dense(ks[3], (DEPTH, 2, D_FF, D_MODEL), D_FF),
        "mix_norm": gain(ks[4], (DEPTH, D_MODEL)),
        "ab_w_in": dense(ks[5], (N_EVEN, D_MODEL, AB_IN), D_MODEL),
        "ab_w_out": dense(ks[6], (N_EVEN, MIX_W, D_MODEL), MIX_W),
        "hgrn_lb_logits": 0.1 * jax.random.normal(ks[7], (DEPTH + 1, HG_HEADS * HG_DK), jnp.float32),
        "hgrn_out_norm": gain(ks[8], (N_EVEN, HG_HEADS, HG_DV)),
        "conv_w": dense(ks[9], (N_EVEN, CONV_W, SC_CH), CONV_W),
        "conv_b": 0.02 * jax.random.normal(ks[10], (N_EVEN, SC_CH), jnp.float32),
        "cd_w_in": dense(ks[11], (N_ODD, D_MODEL, CD_IN), D_MODEL),
        "cd_w_out": dense(ks[12], (N_ODD, MIX_W, D_MODEL), MIX_W),
        "mlstm_gate_bias": gate_bias,
        "mlstm_out_norm": gain(ks[15], (N_ODD, ML_HEADS, ML_DH)),
        "final_norm": gain(ks[16], (D_MODEL,)),
    }


def reference(x, ffn_norm, ffn_w_in, ffn_w_out, mix_norm, ab_w_in, ab_w_out, hgrn_lb_logits,
              hgrn_out_norm, conv_w, conv_b, cd_w_in, cd_w_out, mlstm_gate_bias, mlstm_out_norm,
              final_norm):
    lower_bounds = jnp.cumsum(jax.nn.softmax(hgrn_lb_logits.astype(jnp.float32), axis=0), axis=0)
    for layer in range(DEPTH):
        x = x + 0.5 * swiglu(rms_norm(x, ffn_norm[layer, 0]), ffn_w_in[layer, 0], ffn_w_out[layer, 0])
        h = rms_norm(x, mix_norm[layer])
        if layer % 2 == 0:
            e = layer // 2
            x = x + mixer_ab(h, ab_w_in[e], ab_w_out[e], lower_bounds[layer], hgrn_out_norm[e],
                             conv_w[e], conv_b[e])
        else:
            o = layer // 2
            x = x + mixer_cd(h, cd_w_in[o], cd_w_out[o], mlstm_gate_bias[o], mlstm_out_norm[o])
        x = x + 0.5 * swiglu(rms_norm(x, ffn_norm[layer, 1]), ffn_w_in[layer, 1], ffn_w_out[layer, 1])
    return rms_norm(x, final_norm)
```

```cpp
#include <hip/hip_runtime.h>
#include <hip/hip_cooperative_groups.h>
#include <cstdio>
#include <cstdint>
namespace cg = cooperative_groups;

#ifndef N_LAUNCH_MODE
#define N_LAUNCH_MODE 1
#endif

#define LAS __attribute__((address_space(3)))
typedef unsigned short bf16_t;
typedef short bf16x8 __attribute__((ext_vector_type(8)));
typedef float f32x4 __attribute__((ext_vector_type(4)));
typedef unsigned u32x4 __attribute__((ext_vector_type(4)));
typedef unsigned u32x2 __attribute__((ext_vector_type(2)));

constexpr int M_ = 16384, D_ = 1024, FF_ = 2816, NFF1 = 5632, NAB = 3584, NCD = 3840, SEQ_ = 8192;
constexpr float EPS_ = 1e-6f;

constexpr size_t SZ_W1T = (size_t)NFF1 * D_ * 2, SZ_W2T = (size_t)D_ * FF_ * 2;
constexpr size_t OFF_W1T = 0;
constexpr size_t OFF_W2T = OFF_W1T + 4 * SZ_W1T;
constexpr size_t OFF_ABIN = OFF_W2T + 4 * SZ_W2T;
constexpr size_t OFF_ABOUT = OFF_ABIN + (size_t)NAB * D_ * 2;
constexpr size_t OFF_CDIN = OFF_ABOUT + (size_t)D_ * D_ * 2;
constexpr size_t OFF_CDOUT = OFF_CDIN + (size_t)NCD * D_ * 2;
constexpr size_t OFF_XB = OFF_CDOUT + (size_t)D_ * D_ * 2;
constexpr size_t OFF_SS = OFF_XB + (size_t)M_ * D_ * 2;
constexpr size_t OFF_GATES = OFF_SS + (size_t)M_ * 16 * 4;
constexpr size_t OFF_HP = OFF_GATES + (size_t)M_ * 8 * 4;
constexpr size_t OFF_Y = OFF_HP + (size_t)M_ * NCD * 2;
constexpr size_t OFF_OLOC = OFF_Y + (size_t)M_ * D_ * 2;
constexpr size_t OFF_ST = OFF_OLOC + (size_t)M_ * 512 * 4;
constexpr size_t OFF_DEC = OFF_ST + (size_t)256 * 16384 * 4;
constexpr size_t OFF_NS = OFF_DEC + (size_t)256 * 128 * 4;
constexpr size_t OFF_DENL = OFF_NS + (size_t)256 * 128 * 4;
constexpr size_t OFF_CUMF = OFF_DENL + (size_t)M_ * 4 * 4;
constexpr size_t OFF_DSEG = OFF_CUMF + (size_t)M_ * 4 * 4;
constexpr size_t OFF_KMEAN = OFF_DSEG + 1024;
constexpr size_t OFF_LB = OFF_KMEAN + (size_t)2 * 4 * 32 * 128 * 4;
constexpr size_t OFF_RS = OFF_LB + 2048;
constexpr size_t OFF_BAR = OFF_RS + (size_t)M_ * 4;
constexpr size_t WS_END = OFF_BAR + 16384;

struct Params {
    const float* x; const float* ffn_norm; const float* ffn_w_in; const float* ffn_w_out; const float* mix_norm;
    const float* ab_w_in; const float* ab_w_out; const float* lb_logits; const float* hg_norm; const float* conv_w; const float* conv_b;
    const float* cd_w_in; const float* cd_w_out; const float* gate_bias; const float* ml_norm; const float* final_norm;
    float* out; unsigned char* ws;
};

__device__ __forceinline__ int ltid() { int t = (int)threadIdx.x; asm volatile("" : "+v"(t)); return t; }
__device__ __forceinline__ float bf2f(unsigned short b) { return __uint_as_float(((unsigned)b) << 16); }
typedef float f32x2_t __attribute__((ext_vector_type(2)));
typedef __bf16 bf16x2_t __attribute__((ext_vector_type(2)));
__device__ __forceinline__ unsigned cvt_pk_bf16(float lo, float hi) { f32x2_t v = {lo, hi}; bf16x2_t b = __builtin_convertvector(v, bf16x2_t); return __builtin_bit_cast(unsigned, b); }
__device__ __forceinline__ unsigned short f2bf(float f) { return (unsigned short)(cvt_pk_bf16(f, 0.f) & 0xFFFFu); }
__device__ __forceinline__ unsigned pk2(float lo, float hi) { return cvt_pk_bf16(lo, hi); }
__device__ __forceinline__ float sigmoidf_(float x) { return __builtin_amdgcn_rcpf(1.0f + __expf(-x)); }
__device__ __forceinline__ void lds_barrier() { asm volatile("s_waitcnt lgkmcnt(0)" ::: "memory"); __builtin_amdgcn_s_barrier(); asm volatile("" ::: "memory"); }
__device__ __forceinline__ float wave_sum(float v) {
#pragma unroll
    for (int o = 32; o >= 1; o >>= 1) v += __shfl_xor(v, o);
    return v;
}
__device__ __forceinline__ float wave_max(float v) {
#pragma unroll
    for (int o = 32; o >= 1; o >>= 1) v = fmaxf(v, __shfl_xor(v, o));
    return v;
}

namespace pg8 {
constexpr int BM = 256, BK = 64, HALF = 128, HTB = HALF * BK * 2, STAGE_BYTES = 8 * HTB, NXCD = 8, WGM = 4;
__host__ __device__ __forceinline__ int lds_byte(int r, int c) { const int st = (r >> 4) * 2 + (c >> 5), rr = r & 15, cc = c & 31, ob = rr * 64 + cc * 2; return st * 1024 + (ob ^ (((ob >> 9) & 1) << 5)); }
__host__ __device__ __forceinline__ void stage_rc(int b, int& R, int& C) { const int st = b / 1024, sb = b % 1024, swz = sb ^ (((sb >> 9) & 1) << 5); R = (st >> 1) * 16 + swz / 64; C = (st & 1) * 32 + (swz % 64) / 2; }
__host__ __device__ __forceinline__ int perm32(int rho) { const int n = rho >> 4, i = rho & 15; return 8 * (i >> 2) + 4 * n + (i & 3); }
struct Unit { int pm, pn; };
struct Gemm { const bf16_t* A; const bf16_t* Bt; int M, N, K; };
struct StaticOrder {
    int nM, nN, nwg, G, c;
    __host__ __device__ void init(int M, int N, int G_, int c_) { nM = M / BM; nN = N / BM; nwg = nM * nN; G = G_; c = c_; }
    __host__ __device__ bool next(int i, Unit& u) const {
        const long L = (long)i * G + c; if (L >= nwg) return false;
        int wgid = (int)L; { const int q = nwg / NXCD, r = nwg % NXCD, xcd = wgid % NXCD, off = wgid / NXCD; wgid = (xcd < r ? xcd * (q + 1) : r * (q + 1) + (xcd - r) * q) + off; }
        const int nig = WGM * nN, gid = wgid / nig, fm = gid * WGM, gsz = (nM - fm) < WGM ? (nM - fm) : WGM;
        u.pm = fm + ((wgid % nig) % gsz); u.pn = (wgid % nig) / gsz; return true;
    }
};

template <class Epi>
__device__ __forceinline__ void gemm_phase(LAS unsigned char* lds, const Gemm g, const StaticOrder& S, const Epi& E) {
    const int tid = ltid(), wid = __builtin_amdgcn_readfirstlane(tid >> 6), lane = tid & 63, wr = wid >> 2, wc = wid & 3, fr = lane & 15, fq = lane >> 4;
    const int K = g.K, nt = K / BK;
    unsigned voffA[2], voffB[2];
#pragma unroll
    for (int i = 0; i < 2; ++i) { int R, C; stage_rc(tid * 16 + i * 8192, R, C); const int Rb = ((R & ~31) + perm32(R & 31));
        voffA[i] = (unsigned)(R * K + C) * 2u; voffB[i] = (unsigned)(Rb * K + C) * 2u; }
    const size_t kstep = (size_t)(BK * 2);
    const size_t hstep = (size_t)HALF * K * 2;
    const size_t tstep = 2 * hstep;
    const unsigned ldsw = (unsigned)wid * 1024u;
    const int aoff = lds_byte(wr * 64 + fr, fq * 8), boff = lds_byte(wc * 32 + fr, fq * 8);
#define PG8_SA(b, h) (((b) * 2 + (h)) * HTB)
#define PG8_SB(b, h) ((4 + (b) * 2 + (h)) * HTB)
#define PG8_STAGE(bufoff, gbase, voff) do { _Pragma("unroll") for (int _i = 0; _i < 2; ++_i) \
        __builtin_amdgcn_global_load_lds((const unsigned*)((const char*)(gbase) + (voff)[_i]), (LAS unsigned*)(lds + (bufoff) + ldsw + _i * 8192), 16, 0, 0); } while (0)
#define PG8_LDA(dst, b, h) do { _Pragma("unroll") for (int m = 0; m < 4; ++m) _Pragma("unroll") for (int k = 0; k < 2; ++k) dst[m][k] = *(const LAS bf16x8*)(lds + PG8_SA(b, h) + aoff + m * 2048 + k * 1024); } while (0)
#define PG8_LDB(dst, b, h) do { _Pragma("unroll") for (int n = 0; n < 2; ++n) _Pragma("unroll") for (int k = 0; k < 2; ++k) dst[n][k] = *(const LAS bf16x8*)(lds + PG8_SB(b, h) + boff + n * 2048 + k * 1024); } while (0)
#define PG8_MMA(ai, bj, At, Bt) do { __builtin_amdgcn_s_setprio(1); _Pragma("unroll") for (int m = 0; m < 4; ++m) _Pragma("unroll") for (int n = 0; n < 2; ++n) _Pragma("unroll") for (int k = 0; k < 2; ++k) \
        acc[ai][bj][m][n] = __builtin_amdgcn_mfma_f32_16x16x32_bf16(Bt[n][k], At[m][k], acc[ai][bj][m][n], 0, 0, 0); __builtin_amdgcn_s_setprio(0); } while (0)
#define PG8_WAIT_V(n) asm volatile("s_waitcnt vmcnt(" #n ")" ::: "memory")
#define PG8_WAIT_L(n) asm volatile("s_waitcnt lgkmcnt(" #n ")" ::: "memory")
#define PG8_BAR __builtin_amdgcn_s_barrier()
#define PG8_SCHED __builtin_amdgcn_sched_barrier(0)
    Unit cur, nxt; int ui = 0;
    if (!S.next(0, cur)) return;
    f32x4 acc[2][2][4][2];
#pragma unroll
    for (int a = 0; a < 2; ++a)
#pragma unroll
        for (int b = 0; b < 2; ++b)
#pragma unroll
            for (int m = 0; m < 4; ++m)
#pragma unroll
                for (int n = 0; n < 2; ++n) acc[a][b][m][n] = (f32x4){0.f, 0.f, 0.f, 0.f};
    bf16x8 At[4][2], B0[2][2], B1[2][2];
    const char* cA = (const char*)g.A + (size_t)cur.pm * tstep; const char* cB = (const char*)g.Bt + (size_t)cur.pn * tstep;
    typename Epi::Pre epre = E.prefetch(cur, wr, fr);
    PG8_STAGE(PG8_SB(0, 0), cB, voffB); PG8_STAGE(PG8_SB(0, 1), cB + hstep, voffB); PG8_STAGE(PG8_SA(0, 0), cA, voffA); PG8_STAGE(PG8_SA(0, 1), cA + hstep, voffA);
    if (wr == 1) PG8_BAR;
    PG8_WAIT_V(2); PG8_BAR;
    PG8_STAGE(PG8_SB(1, 0), cB + kstep, voffB); PG8_STAGE(PG8_SA(1, 0), cA + kstep, voffA); PG8_STAGE(PG8_SB(1, 1), cB + hstep + kstep, voffB);
    PG8_WAIT_V(6); PG8_BAR;
    for (;;) {
        const bool has_next = S.next(ui + 1, nxt);
        const char* nA = has_next ? (const char*)g.A + (size_t)nxt.pm * tstep : cA; const char* nB = has_next ? (const char*)g.Bt + (size_t)nxt.pn * tstep : cB;
        for (int t = 0; t < nt; t += 2) {
            const bool last = (t == nt - 2);
            const char* a1 = cA + (size_t)(t + 1) * kstep;
            const char* a2 = last ? nA : cA + (size_t)(t + 2) * kstep; const char* b2 = last ? nB : cB + (size_t)(t + 2) * kstep;
            const char* a3 = a2 + kstep; const char* b3 = b2 + kstep;
            PG8_LDB(B0, 0, 0); PG8_LDB(B1, 0, 1); PG8_SCHED; PG8_LDA(At, 0, 0); PG8_STAGE(PG8_SA(1, 1), a1 + hstep, voffA);
            PG8_WAIT_V(8); PG8_WAIT_L(0); PG8_BAR; PG8_MMA(0, 0, At, B0); PG8_MMA(0, 1, At, B1); PG8_BAR; PG8_SCHED;
            PG8_LDA(At, 0, 1); PG8_STAGE(PG8_SB(0, 0), b2, voffB); PG8_STAGE(PG8_SB(0, 1), b2 + hstep, voffB); PG8_STAGE(PG8_SA(0, 0), a2, voffA);
            PG8_WAIT_V(8); PG8_WAIT_L(0); PG8_BAR; PG8_MMA(1, 0, At, B0); PG8_MMA(1, 1, At, B1); PG8_BAR; PG8_SCHED;
            PG8_LDB(B0, 1, 0); PG8_LDB(B1, 1, 1); PG8_SCHED; PG8_LDA(At, 1, 0); PG8_STAGE(PG8_SA(0, 1), a2 + hstep, voffA);
            PG8_WAIT_V(8); PG8_WAIT_L(0); PG8_BAR; PG8_MMA(0, 0, At, B0); PG8_MMA(0, 1, At, B1); PG8_BAR; PG8_SCHED;
            PG8_LDA(At, 1, 1); PG8_STAGE(PG8_SB(1, 0), b3, voffB); PG8_STAGE(PG8_SB(1, 1), b3 + hstep, voffB); PG8_STAGE(PG8_SA(1, 0), a3, voffA);
            PG8_WAIT_V(8); PG8_WAIT_L(0); PG8_BAR; PG8_MMA(1, 0, At, B0); PG8_MMA(1, 1, At, B1); PG8_BAR; PG8_SCHED;
        }
        if (wr == 0) PG8_BAR;
        E(acc, cur, wr, wc, fr, fq, epre);
        if (!has_next) break;
#pragma unroll
        for (int a = 0; a < 2; ++a)
#pragma unroll
            for (int b = 0; b < 2; ++b)
#pragma unroll
                for (int m = 0; m < 4; ++m)
#pragma unroll
                    for (int n = 0; n < 2; ++n) acc[a][b][m][n] = (f32x4){0.f, 0.f, 0.f, 0.f};
        cur = nxt; cA = nA; cB = nB; ++ui;
        epre = E.prefetch(cur, wr, fr);
        if (wr == 1) PG8_BAR;
    }
    PG8_WAIT_V(0);
    PG8_BAR;
#undef PG8_SA
#undef PG8_SB
#undef PG8_STAGE
#undef PG8_LDA
#undef PG8_LDB
#undef PG8_MMA
#undef PG8_WAIT_V
#undef PG8_WAIT_L
#undef PG8_BAR
#undef PG8_SCHED
}
}

__device__ __forceinline__ float row_rstd(const float* ss, int row) {
    const f32x4* sp = (const f32x4*)(ss + (size_t)row * 16);
    const f32x4 a = sp[0], b = sp[1], c = sp[2], d = sp[3];
    const float s = ((a[0] + a[1]) + (a[2] + a[3])) + ((b[0] + b[1]) + (b[2] + b[3])) + ((c[0] + c[1]) + (c[2] + c[3])) + ((d[0] + d[1]) + (d[2] + d[3]));
    return rsqrtf(s * (1.0f / D_) + EPS_);
}

struct EpiSwiglu {
    bf16_t* H; const float* rsv;
    struct Pre { float r[8]; };
    __device__ __forceinline__ Pre prefetch(const pg8::Unit& u, int wr, int fr) const {
        Pre p; const int row0 = u.pm * 256 + wr * 64 + fr;
#pragma unroll
        for (int i = 0; i < 8; ++i) p.r[i] = rsv[row0 + (i >> 2) * 128 + (i & 3) * 16];
        return p;
    }
    __device__ __forceinline__ void operator()(const f32x4 (&acc)[2][2][4][2], const pg8::Unit& u, int wr, int wc, int fr, int fq, const Pre& pre) const {
        const int row0 = u.pm * 256 + wr * 64 + fr, col0 = u.pn * 128 + wc * 32 + 8 * fq;
#pragma unroll
        for (int ai = 0; ai < 2; ++ai)
#pragma unroll
            for (int m = 0; m < 4; ++m) {
                const int row = row0 + ai * 128 + m * 16;
                const float rs = pre.r[ai * 4 + m], rs2 = rs * rs, nrl = rs * -1.4426950408889634f;
                float hv[8];
#pragma unroll
                for (int n = 0; n < 2; ++n)
#pragma unroll
                    for (int j = 0; j < 4; ++j) { const float ag = acc[ai][0][m][n][j], au = acc[ai][1][m][n][j]; hv[n * 4 + j] = (ag * au) * rs2 * __builtin_amdgcn_rcpf(1.0f + __builtin_amdgcn_exp2f(ag * nrl)); }
                u32x4 w; w.x = pk2(hv[0], hv[1]); w.y = pk2(hv[2], hv[3]); w.z = pk2(hv[4], hv[5]); w.w = pk2(hv[6], hv[7]);
                *(u32x4*)(H + (size_t)row * FF_ + col0) = w;
            }
    }
};
struct EpiResid {
    const float* Xin; float* Xout; bf16_t* XB; float* ss; float scale; int write_xb;
    struct Pre {};
    __device__ __forceinline__ Pre prefetch(const pg8::Unit&, int, int) const { return Pre{}; }
    __device__ __forceinline__ void operator()(const f32x4 (&acc)[2][2][4][2], const pg8::Unit& u, int wr, int wc, int fr, int fq, const Pre&) const {
        const int row0 = u.pm * 256 + wr * 64 + fr, col0 = u.pn * 256 + wc * 32 + 8 * fq;
        f32x4 xw[3][2][2];
#define ER_LOAD(s_) do { const size_t o_ = (size_t)(row0 + ((s_) >> 2) * 128 + ((s_) & 3) * 16) * D_ + col0; _Pragma("unroll") for (int bj = 0; bj < 2; ++bj) { \
            xw[(s_) % 3][bj][0] = *(const f32x4*)(Xin + o_ + bj * 128); xw[(s_) % 3][bj][1] = *(const f32x4*)(Xin + o_ + bj * 128 + 4); } } while (0)
        ER_LOAD(0); ER_LOAD(1);
#pragma unroll
        for (int s = 0; s < 8; ++s) {
            if (s + 2 < 8) ER_LOAD(s + 2);
            const int ai = s >> 2, m = s & 3;
            const int row = row0 + ai * 128 + m * 16;
            float sq = 0.f;
#pragma unroll
            for (int bj = 0; bj < 2; ++bj) {
                const size_t o = (size_t)row * D_ + col0 + bj * 128;
                const f32x4 x0 = xw[s % 3][bj][0] + acc[ai][bj][m][0] * scale, x1 = xw[s % 3][bj][1] + acc[ai][bj][m][1] * scale;
                __builtin_nontemporal_store(x0, (f32x4*)(Xout + o)); __builtin_nontemporal_store(x1, (f32x4*)(Xout + o + 4));
                u32x4 w; w.x = pk2(x0[0], x0[1]); w.y = pk2(x0[2], x0[3]); w.z = pk2(x1[0], x1[1]); w.w = pk2(x1[2], x1[3]);
                if (write_xb) *(u32x4*)(XB + o) = w;
                sq += (x0[0] * x0[0] + x0[1] * x0[1]) + (x0[2] * x0[2] + x0[3] * x0[3]) + (x1[0] * x1[0] + x1[1] * x1[1]) + (x1[2] * x1[2] + x1[3] * x1[3]);
            }
            sq += __shfl_xor(sq, 16); sq += __shfl_xor(sq, 32);
            if (fq == 0) ss[(size_t)row * 16 + u.pn * 4 + wc] = sq;
        }
#undef ER_LOAD
    }
};
struct EpiProj {
    bf16_t* Pj; int ldp; const float* rsv; float* gates; int gate_col0;
    struct Pre { float r[8]; };
    __device__ __forceinline__ Pre prefetch(const pg8::Unit& u, int wr, int fr) const {
        Pre p; const int row0 = u.pm * 256 + wr * 64 + fr;
#pragma unroll
        for (int i = 0; i < 8; ++i) p.r[i] = rsv[row0 + (i >> 2) * 128 + (i & 3) * 16];
        return p;
    }
    __device__ __forceinline__ void operator()(const f32x4 (&acc)[2][2][4][2], const pg8::Unit& u, int wr, int wc, int fr, int fq, const Pre& pre) const {
        const int row0 = u.pm * 256 + wr * 64 + fr, col0 = u.pn * 256 + wc * 32 + 8 * fq;
#pragma unroll
        for (int ai = 0; ai < 2; ++ai)
#pragma unroll
            for (int m = 0; m < 4; ++m) {
                const int row = row0 + ai * 128 + m * 16;
                const float rs = pre.r[ai * 4 + m];
#pragma unroll
                for (int bj = 0; bj < 2; ++bj) {
                    const f32x4 v0 = acc[ai][bj][m][0] * rs, v1 = acc[ai][bj][m][1] * rs;
                    u32x4 w; w.x = pk2(v0[0], v0[1]); w.y = pk2(v0[2], v0[3]); w.z = pk2(v1[0], v1[1]); w.w = pk2(v1[2], v1[3]);
                    if (col0 + bj * 128 < 3584) *(u32x4*)(Pj + (size_t)row * ldp + col0 + bj * 128) = w;
                    if (gates != nullptr && bj == 0 && col0 == gate_col0) { *(f32x4*)(gates + (size_t)row * 8) = v0; *(f32x4*)(gates + (size_t)row * 8 + 4) = v1; }
                }
            }
    }
};

struct ConvJob { const float* W; const float* gain; bf16_t* out; int ldw, K, k0, n0, mode; };
constexpr int T_W1 = 16 * 44, T_W2 = 44 * 8, T_ABI = 16 * 28, T_SQ = 16 * 8, T_CDI = 16 * 30;
__host__ __device__ constexpr int conv_ntiles(int m) { return m < 0 ? 0 : (m < 4 ? T_W1 : (m < 8 ? T_W2 : (m == 8 ? T_ABI : (m == 10 ? T_CDI : T_SQ)))); }
__device__ __forceinline__ ConvJob conv_decode_m(const Params& P, int m, int t) {
    ConvJob j; unsigned char* ws = P.ws; int ntn;
    if (m < 4) { j.W = P.ffn_w_in + (size_t)m * D_ * NFF1; j.gain = P.ffn_norm + (size_t)m * D_; j.out = (bf16_t*)(ws + OFF_W1T + m * SZ_W1T); j.ldw = NFF1; j.K = D_; j.mode = 1; ntn = 44; }
    else if (m < 8) { const int i = m - 4; j.W = P.ffn_w_out + (size_t)i * FF_ * D_; j.gain = nullptr; j.out = (bf16_t*)(ws + OFF_W2T + i * SZ_W2T); j.ldw = D_; j.K = FF_; j.mode = 0; ntn = 8; }
    else if (m == 8) { j.W = P.ab_w_in; j.gain = P.mix_norm; j.out = (bf16_t*)(ws + OFF_ABIN); j.ldw = NAB; j.K = D_; j.mode = 0; ntn = 28; }
    else if (m == 9) { j.W = P.ab_w_out; j.gain = nullptr; j.out = (bf16_t*)(ws + OFF_ABOUT); j.ldw = D_; j.K = D_; j.mode = 0; ntn = 8; }
    else if (m == 10) { j.W = P.cd_w_in; j.gain = P.mix_norm + D_; j.out = (bf16_t*)(ws + OFF_CDIN); j.ldw = 3592; j.K = D_; j.mode = 2; ntn = 30; }
    else { j.W = P.cd_w_out; j.gain = nullptr; j.out = (bf16_t*)(ws + OFF_CDOUT); j.ldw = D_; j.K = D_; j.mode = 0; ntn = 8; }
    j.k0 = (t / ntn) * 64; j.n0 = (t % ntn) * 128;
    return j;
}
__device__ __forceinline__ void conv_load(const ConvJob& j, int tid, f32x4 (&r)[4]) {
#pragma unroll
    for (int i = 0; i < 4; ++i) {
        const int c = tid + 512 * i, kk = c >> 5, n4 = (c & 31) * 4, nn = n4 & 63, n0h = j.n0 + (n4 & 64);
        int src0 = n0h, cnt = 64;
        if (j.mode == 1) { const int pn = n0h >> 8, within = n0h & 255, bj = within >> 7, off = within & 127; src0 = bj * FF_ + pn * 128 + off; }
        else if (j.mode == 2) { if (n0h < 2048) src0 = n0h; else if (n0h < 3584) src0 = n0h + 8; else if (n0h == 3584) { src0 = 2048; cnt = 8; } else { src0 = 0; cnt = 0; } }
        f32x4 v = (f32x4){0.f, 0.f, 0.f, 0.f};
        if (nn < cnt) { v = *(const f32x4*)(j.W + (size_t)(j.k0 + kk) * j.ldw + src0 + nn); if (j.gain) v = v * j.gain[j.k0 + kk]; }
        r[i] = v;
    }
}
template <int M0, int M1, int M2, int M3>
__device__ __forceinline__ void conv_batch(const Params& P, float* tile, int worker, int nworkers) {
    constexpr int n0 = conv_ntiles(M0), n1 = n0 + conv_ntiles(M1), n2 = n1 + conv_ntiles(M2), n3 = n2 + conv_ntiles(M3);
    const int tid = ltid();
    int t = worker;
    if (t >= n3) return;
#define CONV_DEC(t_) ((t_) < n0 ? conv_decode_m(P, M0, (t_)) : ((t_) < n1 ? conv_decode_m(P, M1, (t_) - n0) : ((t_) < n2 ? conv_decode_m(P, M2, (t_) - n1) : conv_decode_m(P, M3, (t_) - n2))))
    ConvJob j = CONV_DEC(t);
    f32x4 r[4];
    conv_load(j, tid, r);
    for (;;) {
#pragma unroll
        for (int i = 0; i < 4; ++i) { const int c = tid + 512 * i, kk = c >> 5, n4 = (c & 31) * 4; float* tp = tile + kk * 129 + n4; tp[0] = r[i][0]; tp[1] = r[i][1]; tp[2] = r[i][2]; tp[3] = r[i][3]; }
        const ConvJob cur = j;
        const int tn = t + nworkers; const bool more = tn < n3;
        if (more) { j = CONV_DEC(tn); conv_load(j, tid, r); }
        __syncthreads();
        {
            const int nn = tid >> 2, kq = (tid & 3) * 16;
            const float* tp = tile + kq * 129 + nn;
            u32x4 w0, w1;
            w0.x = pk2(tp[0 * 129], tp[1 * 129]); w0.y = pk2(tp[2 * 129], tp[3 * 129]); w0.z = pk2(tp[4 * 129], tp[5 * 129]); w0.w = pk2(tp[6 * 129], tp[7 * 129]);
            w1.x = pk2(tp[8 * 129], tp[9 * 129]); w1.y = pk2(tp[10 * 129], tp[11 * 129]); w1.z = pk2(tp[12 * 129], tp[13 * 129]); w1.w = pk2(tp[14 * 129], tp[15 * 129]);
            bf16_t* op = cur.out + (size_t)(cur.n0 + nn) * cur.K + cur.k0 + kq;
            *(u32x4*)op = w0; *(u32x4*)(op + 8) = w1;
        }
        __syncthreads();
        if (!more) break;
        t = tn;
    }
#undef CONV_DEC
}
template <class Epi> __device__ __forceinline__ void run_gemm(LAS unsigned char* lds, const bf16_t* A, const bf16_t* Bt, int N, int K, const Epi& E, const float* ss, float* rsv, const Params& P, unsigned char* lds_generic, int cbatch) {
    pg8::Gemm g{A, Bt, M_, N, K}; pg8::StaticOrder S; S.init(M_, N, (int)gridDim.x, (int)blockIdx.x);
    if (rsv != nullptr) {
        const int tid = ltid(), r = tid >> 1, hsel = tid & 1;
        f32x4 pa[8], pb[8]; unsigned okm = 0u; int rows[8];
#pragma unroll
        for (int i = 0; i < 8; ++i) {
            pg8::Unit u; const bool ok = S.next(i, u);
            rows[i] = ok ? u.pm * 256 + r : r;
            const f32x4* sp = (const f32x4*)(ss + (size_t)rows[i] * 16 + hsel * 8);
            pa[i] = sp[0]; pb[i] = sp[1];
            okm |= ok ? (1u << i) : 0u;
        }
#pragma unroll
        for (int i = 0; i < 8; ++i) {
            float s = ((pa[i][0] + pa[i][1]) + (pa[i][2] + pa[i][3])) + ((pb[i][0] + pb[i][1]) + (pb[i][2] + pb[i][3]));
            s += __shfl_xor(s, 1);
            if (hsel == 0 && ((okm >> i) & 1u)) rsv[rows[i]] = rsqrtf(s * (1.0f / D_) + EPS_);
        }
        __syncthreads();
    }
    pg8::gemm_phase<Epi>(lds, g, S, E);
    if (cbatch != 0) {
        const int r = S.nwg % S.G;
        if (r != 0 && (int)blockIdx.x >= r) {
            float* tile = (float*)(const_cast<unsigned char*>((const unsigned char*)lds_generic));
            const int worker = (int)blockIdx.x - r, nworkers = S.G - r;
            if (cbatch == 1) conv_batch<1, 5, -1, -1>(P, tile, worker, nworkers);
            else if (cbatch == 2) conv_batch<9, 2, 11, -1>(P, tile, worker, nworkers);
            else if (cbatch == 3) conv_batch<6, 10, 7, -1>(P, tile, worker, nworkers);
            else conv_batch<3, -1, -1, -1>(P, tile, worker, nworkers);
        }
    }
}

__device__ __forceinline__ void phase_prologue(const Params& P, float* L) {
    const int tid = ltid(), bid = blockIdx.x, nb = gridDim.x, wave = tid >> 6, lane = tid & 63;
    unsigned char* ws = P.ws;
    {
        bf16_t* __restrict__ XB = (bf16_t*)(ws + OFF_XB); float* __restrict__ SS = (float*)(ws + OFF_SS); const float* __restrict__ xin_ = P.x;
        for (int row = bid * 8 + wave; row < M_; row += nb * 8) {
            const f32x4* xr = (const f32x4*)(xin_ + (size_t)row * D_);
            float sq = 0.f;
#pragma unroll
            for (int i = 0; i < 4; ++i) {
                const f32x4 v = xr[lane + 64 * i];
                sq += (v[0] * v[0] + v[1] * v[1]) + (v[2] * v[2] + v[3] * v[3]);
                u32x2 pk; pk.x = pk2(v[0], v[1]); pk.y = pk2(v[2], v[3]);
                *(u32x2*)(XB + (size_t)row * D_ + (lane + 64 * i) * 4) = pk;
            }
            sq = wave_sum(sq);
            if (lane < 16) SS[(size_t)row * 16 + lane] = (lane == 0) ? sq : 0.f;
        }
    }
    conv_batch<0, 4, 8, -1>(P, L, (int)blockIdx.x, (int)gridDim.x);
    if (bid == 0) {
        float* LB = (float*)(ws + OFF_LB);
        const float l0 = P.lb_logits[tid], l1 = P.lb_logits[512 + tid], l2 = P.lb_logits[1024 + tid];
        const float mx = fmaxf(l0, fmaxf(l1, l2)), e0 = __expf(l0 - mx), e1 = __expf(l1 - mx), e2 = __expf(l2 - mx);
        LB[tid] = e0 / (e0 + e1 + e2);
    }
}

__device__ __forceinline__ void phase_conv(const Params& P) {
    const bf16_t* __restrict__ PJ = (const bf16_t*)(P.ws + OFF_HP); bf16_t* __restrict__ Y = (bf16_t*)(P.ws + OFF_Y);
    const int ch = ltid();
    const float w0 = P.conv_w[ch], w1 = P.conv_w[512 + ch], w2 = P.conv_w[1024 + ch], cb = P.conv_b[ch];
    for (int blk = blockIdx.x; blk < M_ / 64; blk += gridDim.x) {
        const int r0 = blk * 64;
        float z2 = 0.f, z1 = 0.f;
        if ((r0 & (SEQ_ - 1)) != 0) {
            const bf16_t* a = PJ + (size_t)(r0 - 2) * NAB; const bf16_t* c = PJ + (size_t)(r0 - 1) * NAB;
            z2 = bf2f(a[2560 + ch]) * bf2f(a[3072 + ch]); z1 = bf2f(c[2560 + ch]) * bf2f(c[3072 + ch]);
        }
#pragma unroll 1
        for (int t0 = 0; t0 < 64; t0 += 16) {
            bf16_t rb[16], rc[16], ru[16];
#pragma unroll
            for (int t = 0; t < 16; ++t) { const bf16_t* r = PJ + (size_t)(r0 + t0 + t) * NAB; rb[t] = r[2048 + ch]; rc[t] = r[2560 + ch]; ru[t] = r[3072 + ch]; }
#pragma unroll
            for (int t = 0; t < 16; ++t) {
                const float z0 = bf2f(rc[t]) * bf2f(ru[t]);
                const float y = bf2f(rb[t]) * (cb + w0 * z2 + w1 * z1 + w2 * z0);
                Y[(size_t)(r0 + t0 + t) * D_ + 512 + ch] = f2bf(y);
                z2 = z1; z1 = z0;
            }
        }
    }
}
__device__ __forceinline__ void phase_scan(float* ST, const float* DEC, int per_channel) {
    for (int gid = blockIdx.x * 512 + ltid(); gid < 8 * 16384; gid += gridDim.x * 512) {
        const int bh = gid >> 14, dv = gid & 16383, d = dv & 127;
        float tv[32], dc[32];
#pragma unroll
        for (int p = 0; p < 32; ++p) { const int w = bh * 32 + p; tv[p] = ST[(size_t)w * 16384 + dv]; dc[p] = per_channel ? DEC[w * 128 + d] : DEC[w]; }
        float S = 0.f;
#pragma unroll
        for (int p = 0; p < 32; ++p) { const int w = bh * 32 + p; ST[(size_t)w * 16384 + dv] = S; S = dc[p] * S + tv[p]; }
    }
}
__device__ __forceinline__ void phase_scan_n(float* NS, const float* DSEG) {
    for (int gid = blockIdx.x * 512 + ltid(); gid < 8 * 128; gid += gridDim.x * 512) {
        const int bh = gid >> 7, d = gid & 127;
        float tv[32], dc[32];
#pragma unroll
        for (int p = 0; p < 32; ++p) { const int w = bh * 32 + p; tv[p] = NS[w * 128 + d]; dc[p] = DSEG[w]; }
        float S = 0.f;
#pragma unroll
        for (int p = 0; p < 32; ++p) { const int w = bh * 32 + p; NS[w * 128 + d] = S; S = dc[p] * S + tv[p]; }
    }
}
__device__ __forceinline__ void phase_moba_pre(const Params& P, float* L) {
    bf16_t* PJ = (bf16_t*)(P.ws + OFF_HP); float* KM = (float*)(P.ws + OFF_KMEAN);
    const int tid = ltid();
    const float qscale = 0.08838834764831845f;
    for (int w = blockIdx.x; w < 256; w += gridDim.x) {
        const int b = w >> 7, n = (w >> 2) & 31, h = w & 3;
        const int row0 = b * SEQ_ + n * 256;
        __syncthreads();
        {
            float q1[8], q2[8], k1[8], k2[8];
#pragma unroll
            for (int u = 0; u < 8; ++u) {
                const int e = tid + 512 * u, t = e >> 4, i = e & 15;
                const bf16_t* qp = PJ + (size_t)(row0 + t) * NCD + 2048 + h * 128 + i;
                const bf16_t* kp = PJ + (size_t)(row0 + t) * NCD + 2560 + h * 128 + i;
                q1[u] = bf2f(qp[0]); q2[u] = bf2f(qp[16]); k1[u] = bf2f(kp[0]); k2[u] = bf2f(kp[16]);
            }
#pragma unroll
            for (int u = 0; u < 8; ++u) {
                const int e = tid + 512 * u, t = e >> 4, i = e & 15;
                const int pos = n * 256 + t;
                const float invf = exp2f(-(float)i * (18.931568569324174f / 16.0f));
                const float ang = (float)pos * invf;
                double rev = (double)ang * 0.15915494309189535; rev -= rint(rev);
                const float sn = __builtin_amdgcn_sinf((float)rev), cs = __builtin_amdgcn_cosf((float)rev);
                bf16_t* qp = PJ + (size_t)(row0 + t) * NCD + 2048 + h * 128 + i;
                bf16_t* kp = PJ + (size_t)(row0 + t) * NCD + 2560 + h * 128 + i;
                qp[0] = f2bf(q1[u] * cs - q2[u] * sn); qp[16] = f2bf(q2[u] * cs + q1[u] * sn);
                kp[0] = f2bf(k1[u] * cs - k2[u] * sn); kp[16] = f2bf(k2[u] * cs + k1[u] * sn);
            }
        }
        __syncthreads();
        {
            const int col = tid & 127, tq = tid >> 7;
            float s = 0.f;
            for (int t = 0; t < 64; ++t) s += bf2f(PJ[(size_t)(row0 + tq * 64 + t) * NCD + 2560 + h * 128 + col]);
            L[tq * 128 + col] = s;
        }
        __syncthreads();
        if (tid < 128) KM[(size_t)((b * 4 + h) * 32 + n) * 128 + tid] = ((L[tid] + L[128 + tid]) + (L[256 + tid] + L[384 + tid])) * (1.0f / 256.0f);
        {
            bf16_t* VT = (bf16_t*)(P.ws + OFF_W1T);
            unsigned char* T = (unsigned char*)L + 4096;
#pragma unroll 2
            for (int i = 0; i < 8; ++i) { const int c = tid + 512 * i, r = c >> 4, c16 = c & 15;
                *(u32x4*)(T + r * 272 + c16 * 16) = *(const u32x4*)(PJ + (size_t)(row0 + r) * NCD + 3072 + h * 128 + c16 * 8); }
            __syncthreads();
#pragma unroll 2
            for (int i = 0; i < 8; ++i) { const int c = tid + 512 * i, vcol = c & 127, t8 = c >> 7;
                const unsigned char* tp = T + (t8 * 8) * 272 + vcol * 2;
                u32x4 wv;
                wv.x = (unsigned)*(const bf16_t*)(tp) | ((unsigned)*(const bf16_t*)(tp + 272) << 16);
                wv.y = (unsigned)*(const bf16_t*)(tp + 2 * 272) | ((unsigned)*(const bf16_t*)(tp + 3 * 272) << 16);
                wv.z = (unsigned)*(const bf16_t*)(tp + 4 * 272) | ((unsigned)*(const bf16_t*)(tp + 5 * 272) << 16);
                wv.w = (unsigned)*(const bf16_t*)(tp + 6 * 272) | ((unsigned)*(const bf16_t*)(tp + 7 * 272) << 16);
                *(u32x4*)(VT + (size_t)((b * 4 + h) * 128 + vcol) * SEQ_ + n * 256 + t8 * 8) = wv; }
        }
    }
}
constexpr int MB_S = 272;
constexpr int MB_BUF = 2 * 128 * MB_S;
constexpr int MB_OFF_K = 0, MB_OFF_VT = 128 * MB_S, MB_OFF_KM = MB_BUF, MB_OFF_P = MB_BUF + 16384, MB_OFF_SM = 2 * MB_BUF;
constexpr int LDS_MISC_OFF = 2 * MB_BUF + 512;
constexpr int LDS_TOTAL = LDS_MISC_OFF + 64;
__device__ __forceinline__ void phase_moba_attn_mfma(const Params& P, unsigned char* smem) {
    const bf16_t* PJ = (const bf16_t*)(P.ws + OFF_HP); bf16_t* Y = (bf16_t*)(P.ws + OFF_Y); const float* KM = (const float*)(P.ws + OFF_KMEAN);
    const bf16_t* VT = (const bf16_t*)(P.ws + OFF_W1T);
    const int tid = ltid(), wave = tid >> 6, lane = tid & 63, li = lane & 15, quad = lane >> 4;
    unsigned char* Kl = smem + MB_OFF_K; unsigned char* VTl = smem + MB_OFF_VT; unsigned char* Pw = smem + MB_OFF_P + wave * 16 * MB_S;
    float* KMl = (float*)(smem + MB_OFF_KM); float* SC = (float*)(smem + MB_OFF_P); unsigned* SM = (unsigned*)(smem + MB_OFF_SM);
    const float NEG_INF = -__builtin_inff();
    const float MB_C = 0.08838834764831845f * 1.4426950408889634f;
    for (int w = blockIdx.x; w < 256; w += gridDim.x) {
#pragma unroll 1
        for (int half = 0; half < 2; ++half) {
            const int bh = w & 7, ii = w >> 3, qt = half ? 63 - ii : ii;
            const int b = bh >> 2, h = bh & 3, own = qt >> 1, q0 = qt * 128;
            const size_t rowbase = (size_t)b * SEQ_;
            __syncthreads();
#pragma unroll
            for (int i = 0; i < 4; ++i) { const int c = tid + 512 * i, r = c >> 4, c16 = c & 15;
                *(u32x4*)(Kl + r * MB_S + c16 * 16) = *(const u32x4*)(PJ + (rowbase + q0 + r) * NCD + 2048 + h * 128 + c16 * 8); }
#pragma unroll
            for (int i = 0; i < 2; ++i) { const int c = tid + 512 * i; ((u32x4*)KMl)[c] = ((const u32x4*)(KM + (size_t)(bh * 32) * 128))[c]; }
            __syncthreads();
            {
                const int q = tid & 127, g = tid >> 7;
                float s8[8];
#pragma unroll
                for (int nn = 0; nn < 8; ++nn) s8[nn] = 0.f;
#pragma unroll 2
                for (int d8 = 0; d8 < 16; ++d8) {
                    const u32x4 qw = *(const u32x4*)(Kl + q * MB_S + d8 * 16);
                    const float q0f = __uint_as_float(qw.x << 16), q1f = __uint_as_float(qw.x & 0xFFFF0000u), q2f = __uint_as_float(qw.y << 16), q3f = __uint_as_float(qw.y & 0xFFFF0000u);
                    const float q4f = __uint_as_float(qw.z << 16), q5f = __uint_as_float(qw.z & 0xFFFF0000u), q6f = __uint_as_float(qw.w << 16), q7f = __uint_as_float(qw.w & 0xFFFF0000u);
#pragma unroll
                    for (int nn = 0; nn < 8; ++nn) {
                        const float* km = KMl + (g * 8 + nn) * 128 + d8 * 8;
                        const f32x4 k0 = *(const f32x4*)km, k1 = *(const f32x4*)(km + 4);
                        s8[nn] += (q0f * k0[0] + q1f * k0[1]) + (q2f * k0[2] + q3f * k0[3]) + (q4f * k1[0] + q5f * k1[1]) + (q6f * k1[2] + q7f * k1[3]);
                    }
                }
#pragma unroll
                for (int nn = 0; nn < 8; ++nn) { const int n = g * 8 + nn; SC[q * 33 + n] = (n < own) ? s8[nn] : NEG_INF; }
            }
            __syncthreads();
            if (tid < 128) {
                unsigned mask = 1u << own;
                float sc[32];
#pragma unroll
                for (int n = 0; n < 32; ++n) sc[n] = SC[tid * 33 + n];
#pragma unroll
                for (int r = 0; r < 3; ++r) {
                    float best = NEG_INF; int bi = -1;
#pragma unroll
                    for (int n = 0; n < 32; ++n) { const bool gt = sc[n] > best; best = gt ? sc[n] : best; bi = gt ? n : bi; }
                    if (bi >= 0) mask |= 1u << bi;
#pragma unroll
                    for (int n = 0; n < 32; ++n) sc[n] = (n == bi) ? NEG_INF : sc[n];
                }
                SM[tid] = mask;
            }
            __syncthreads();
            bf16x8 qf[4];
#pragma unroll
            for (int kc = 0; kc < 4; ++kc) qf[kc] = *(const bf16x8*)(Kl + (wave * 16 + li) * MB_S + (kc * 32 + quad * 8) * 2);
            const unsigned smq = SM[wave * 16 + li];
            unsigned wum = smq;
            wum |= __shfl_xor(wum, 1); wum |= __shfl_xor(wum, 2); wum |= __shfl_xor(wum, 4); wum |= __shfl_xor(wum, 8);
            unsigned um = SM[lane] | SM[64 + lane];
#pragma unroll
            for (int o = 32; o >= 1; o >>= 1) um |= __shfl_xor(um, o);
            um = __builtin_amdgcn_readfirstlane(um); wum = __builtin_amdgcn_readfirstlane(wum);
            const int qpos = q0 + wave * 16 + li;
            float m = NEG_INF, l = 0.f; f32x4 O[8];
#pragma unroll
            for (int vt = 0; vt < 8; ++vt) O[vt] = (f32x4){0.f, 0.f, 0.f, 0.f};
            const int nsteps = 2 * (own + 1);
#define MB_N(s_) ((((s_) >> 1) == 0) ? own : (((s_) >> 1) - 1))
#define MB_VALID(s_) ((((um >> MB_N(s_)) & 1u) != 0u) && !((((s_) >> 1) == 0) && ((own * 256 + ((s_) & 1) * 128) > q0 + 127)))
            int step = 0;
            while (step < nsteps && !MB_VALID(step)) ++step;
            int nstep = step + 1;
            while (nstep < nsteps && !MB_VALID(nstep)) ++nstep;
            u32x4 kreg[4], vreg[4];
            const int sr = tid >> 4, sc16 = tid & 15;
#define MB_GLOAD(s_) do { const int k0_ = MB_N(s_) * 256 + ((s_) & 1) * 128; _Pragma("unroll") for (int i = 0; i < 4; ++i) { \
                kreg[i] = *(const u32x4*)(PJ + (rowbase + k0_ + sr + 32 * i) * NCD + 2560 + h * 128 + sc16 * 8); \
                vreg[i] = *(const u32x4*)(VT + (size_t)(bh * 128 + sr + 32 * i) * SEQ_ + k0_ + sc16 * 8); } } while (0)
            const int vperm_lo = (sc16 >> 2) * 64 + (((sc16 & 3) < 2) ? 4 * (sc16 & 3) : 4 * ((sc16 & 3) - 2) + 1) * 8;
#define MB_LWRITE(buf_) do { _Pragma("unroll") for (int i = 0; i < 4; ++i) { *(u32x4*)(smem + (buf_) * MB_BUF + MB_OFF_K + (sr + 32 * i) * MB_S + sc16 * 16) = kreg[i]; \
                unsigned char* vrow_ = smem + (buf_) * MB_BUF + MB_OFF_VT + (sr + 32 * i) * MB_S + vperm_lo; u32x2 lo_, hi_; lo_.x = vreg[i].x; lo_.y = vreg[i].y; hi_.x = vreg[i].z; hi_.y = vreg[i].w; \
                *(u32x2*)vrow_ = lo_; *(u32x2*)(vrow_ + 16) = hi_; } } while (0)
            if (step < nsteps) MB_GLOAD(step);
            lds_barrier();
            if (step < nsteps) { MB_LWRITE(0); if (nstep < nsteps) MB_GLOAD(nstep); }
            int bufi = 0;
#pragma unroll 1
            while (step < nsteps) {
                const int n = MB_N(step), key0 = n * 256 + (step & 1) * 128;
                unsigned char* Kl = smem + bufi * MB_BUF + MB_OFF_K; unsigned char* VTl = smem + bufi * MB_BUF + MB_OFF_VT;
                lds_barrier();
                int nnstep = nstep + 1;
                while (nnstep < nsteps && !MB_VALID(nnstep)) ++nnstep;
                if (nstep < nsteps) { MB_LWRITE(bufi ^ 1); if (nnstep < nsteps) MB_GLOAD(nnstep); }
                if ((wum >> n) & 1u) {
                    f32x4 S[8];
                    {
                        bf16x8 kf[2][4];
#define MB_LDK(slot, st_) do { _Pragma("unroll") for (int kc = 0; kc < 4; ++kc) kf[slot][kc] = *(const bf16x8*)(Kl + ((st_) * 16 + li) * MB_S + (kc * 32 + quad * 8) * 2); } while (0)
                        MB_LDK(0, 0);
#pragma unroll
                        for (int st = 0; st < 8; ++st) {
                            if (st + 1 < 8) MB_LDK((st + 1) & 1, st + 1);
                            __builtin_amdgcn_sched_barrier(0);
                            f32x4 acc = (f32x4){0.f, 0.f, 0.f, 0.f};
#pragma unroll
                            for (int kc = 0; kc < 4; ++kc) acc = __builtin_amdgcn_mfma_f32_16x16x32_bf16(kf[st & 1][kc], qf[kc], acc, 0, 0, 0);
                            S[st] = acc;
                            __builtin_amdgcn_sched_barrier(0);
                        }
#undef MB_LDK
                    }
                    const bool sel = (smq >> n) & 1u;
                    float mj = NEG_INF;
                    if (n == own) {
#pragma unroll
                        for (int st = 0; st < 8; ++st)
#pragma unroll
                            for (int j = 0; j < 4; ++j) { const int kpos = key0 + st * 16 + quad * 4 + j; const float sv = (kpos <= qpos) ? S[st][j] : NEG_INF; S[st][j] = sv; mj = fmaxf(mj, sv); }
                    } else {
#pragma unroll
                        for (int st = 0; st < 8; ++st) mj = fmaxf(fmaxf(mj, fmaxf(S[st][0], S[st][1])), fmaxf(S[st][2], S[st][3]));
                        mj = sel ? mj : NEG_INF;
                    }
                    mj = fmaxf(mj, __shfl_xor(mj, 16)); mj = fmaxf(mj, __shfl_xor(mj, 32));
                    const float mn = fmaxf(m, mj), msafe = (mn == NEG_INF) ? 0.f : mn;
                    const float alpha = __builtin_amdgcn_exp2f((m - msafe) * MB_C);
                    const float mc = sel ? msafe * MB_C : __builtin_inff();
                    float ls = 0.f;
#pragma unroll
                    for (int st = 0; st < 8; ++st)
#pragma unroll
                        for (int j = 0; j < 4; ++j) { const float pe = __builtin_amdgcn_exp2f(fmaf(S[st][j], MB_C, -mc)); S[st][j] = pe; ls += pe; }
                    ls += __shfl_xor(ls, 16); ls += __shfl_xor(ls, 32);
                    l = l * alpha + ls; m = mn;
                    if (__builtin_amdgcn_ballot_w64(alpha != 1.0f) != 0ull) {
#pragma unroll
                        for (int vt = 0; vt < 8; ++vt) O[vt] *= alpha;
                    }
                    {
                        bf16x8 pf[4];
#pragma unroll
                        for (int c = 0; c < 4; ++c) { u32x4 pw; pw.x = cvt_pk_bf16(S[2 * c][0], S[2 * c][1]); pw.y = cvt_pk_bf16(S[2 * c][2], S[2 * c][3]); pw.z = cvt_pk_bf16(S[2 * c + 1][0], S[2 * c + 1][1]); pw.w = cvt_pk_bf16(S[2 * c + 1][2], S[2 * c + 1][3]); pf[c] = __builtin_bit_cast(bf16x8, pw); }
                        u32x4 vfr[4];
#define MB_LDV(slot, g_) do { vfr[slot] = *(const u32x4*)(VTl + ((((g_) & 7) * 16) + li) * MB_S + ((g_) >> 3) * 64 + quad * 16); } while (0)
                        MB_LDV(0, 0); MB_LDV(1, 1); MB_LDV(2, 2);
#pragma unroll
                        for (int g = 0; g < 32; ++g) {
                            if (g + 3 < 32) MB_LDV((g + 3) & 3, g + 3);
                            __builtin_amdgcn_sched_barrier(0);
                            O[g & 7] = __builtin_amdgcn_mfma_f32_16x16x32_bf16(__builtin_bit_cast(bf16x8, vfr[g & 3]), pf[g >> 3], O[g & 7], 0, 0, 0);
                            __builtin_amdgcn_sched_barrier(0);
                        }
#undef MB_LDV
                    }
                }
                step = nstep; nstep = nnstep; bufi ^= 1;
            }
#undef MB_GLOAD
#undef MB_LWRITE
#undef MB_VALID
#undef MB_N
            {
                const float inv = 1.0f / l;
                bf16_t* yp = Y + (rowbase + qpos) * D_ + 512 + h * 128 + quad * 4;
#pragma unroll
                for (int vt = 0; vt < 8; ++vt) { u32x2 w2; w2.x = cvt_pk_bf16(O[vt][0] * inv, O[vt][1] * inv); w2.y = cvt_pk_bf16(O[vt][2] * inv, O[vt][3] * inv); *(u32x2*)(yp + vt * 16) = w2; }
            }
        }
    }
}

constexpr int ML_OFF_K = 0, ML_OFF_VT = 128 * MB_S, ML_OFF_Q = 2 * 128 * MB_S, ML_OFF_TAB = 3 * 128 * MB_S;
__device__ __forceinline__ void phase_mlstm_A2(const Params& P, unsigned char* smem) {
    unsigned char* ws = P.ws;
    const bf16_t* PJ = (const bf16_t*)(ws + OFF_HP); const float* GATES = (const float*)(ws + OFF_GATES);
    float* NUML = (float*)(ws + OFF_OLOC); float* DENL = (float*)(ws + OFF_DENL); float* CUMF = (float*)(ws + OFF_CUMF);
    float* ST = (float*)(ws + OFF_ST); float* NS = (float*)(ws + OFF_NS); float* DSEG = (float*)(ws + OFF_DSEG);
    const int tid = ltid(), wave = tid >> 6, lane = tid & 63, li = lane & 15, quad = lane >> 4;
    unsigned char* Kl = smem + ML_OFF_K; unsigned char* VTl = smem + ML_OFF_VT; unsigned char* Ql = smem + ML_OFF_Q;
    float* Bq = (float*)(smem + ML_OFF_TAB); float* Gk = Bq + 256; float* We = Bq + 512; float* NR = Bq + 768;
    const float qscale = 0.08838834764831845f;
    const int sr = tid >> 4, sc16 = tid & 15;
    const int tr = tid & 31, tc16 = tid >> 5;
    for (int w = blockIdx.x; w < 256; w += gridDim.x) {
        const int b = w >> 7, h = (w >> 5) & 3, p = w & 31;
        const size_t row0 = (size_t)b * SEQ_ + p * 256;
        __syncthreads();
        if (tid < 64) {
            const float bi = P.gate_bias[h], bfg = P.gate_bias[4 + h];
            float lf[4], lg[4];
#pragma unroll
            for (int e = 0; e < 4; ++e) { const float* gp = GATES + (row0 + 4 * lane + e) * 8; lg[e] = gp[h] + bi; const float z = gp[4 + h] + bfg; lf[e] = (z >= 0.f) ? -log1pf(__expf(-z)) : (z - log1pf(__expf(z))); }
            const float c0 = lf[0], c1 = c0 + lf[1], c2 = c1 + lf[2], c3 = c2 + lf[3];
            float inc = c3;
#pragma unroll
            for (int o = 1; o < 64; o <<= 1) { const float up = __shfl_up(inc, o); if (lane >= o) inc += up; }
            const float pre = inc - c3, btot = __shfl(inc, 63);
            const float bb[4] = {pre + c0, pre + c1, pre + c2, pre + c3};
#pragma unroll
            for (int e = 0; e < 4; ++e) { const int t = 4 * lane + e; Bq[t] = bb[e]; Gk[t] = lg[e] - bb[e]; We[t] = __expf(btot - bb[e] + lg[e]); CUMF[(row0 + t) * 4 + h] = __expf(bb[e]); }
            if (lane == 63) DSEG[w] = __expf(btot);
        }
        f32x4 SC[8];
#pragma unroll
        for (int vt = 0; vt < 8; ++vt) SC[vt] = (f32x4){0.f, 0.f, 0.f, 0.f};
        float nacc = 0.f;
        bf16x8 qf[4]; f32x4 O[8]; float dtot = 0.f;
#pragma unroll
        for (int vt = 0; vt < 8; ++vt) O[vt] = (f32x4){0.f, 0.f, 0.f, 0.f};
#pragma unroll
        for (int kc = 0; kc < 4; ++kc) qf[kc] = (bf16x8){0, 0, 0, 0, 0, 0, 0, 0};
#pragma unroll 1
        for (int kt = 0; kt < 2; ++kt) {
            __syncthreads();
#pragma unroll
            for (int i = 0; i < 4; ++i) {
                *(u32x4*)(Kl + (sr + 32 * i) * MB_S + sc16 * 16) = *(const u32x4*)(PJ + (row0 + kt * 128 + sr + 32 * i) * NCD + 512 + h * 128 + sc16 * 8);
                const u32x4 vv = *(const u32x4*)(PJ + (row0 + kt * 128 + tr + 32 * i) * NCD + 1024 + h * 128 + tc16 * 8);
                unsigned char* vp = VTl + (tc16 * 8) * MB_S + (tr + 32 * i) * 2;
                *(bf16_t*)(vp) = (bf16_t)(vv.x & 0xFFFFu); *(bf16_t*)(vp + MB_S) = (bf16_t)(vv.x >> 16);
                *(bf16_t*)(vp + 2 * MB_S) = (bf16_t)(vv.y & 0xFFFFu); *(bf16_t*)(vp + 3 * MB_S) = (bf16_t)(vv.y >> 16);
                *(bf16_t*)(vp + 4 * MB_S) = (bf16_t)(vv.z & 0xFFFFu); *(bf16_t*)(vp + 5 * MB_S) = (bf16_t)(vv.z >> 16);
                *(bf16_t*)(vp + 6 * MB_S) = (bf16_t)(vv.w & 0xFFFFu); *(bf16_t*)(vp + 7 * MB_S) = (bf16_t)(vv.w >> 16);
            }
#pragma unroll 1
            for (int qt = kt; qt < 2; ++qt) {
                __syncthreads();
                if (kt == 0) {
#pragma unroll
                    for (int i = 0; i < 4; ++i) *(u32x4*)(Ql + (sr + 32 * i) * MB_S + sc16 * 16) = *(const u32x4*)(PJ + (row0 + qt * 128 + sr + 32 * i) * NCD + h * 128 + sc16 * 8);
                    __syncthreads();
#pragma unroll
                    for (int kc = 0; kc < 4; ++kc) qf[kc] = *(const bf16x8*)(Ql + (wave * 16 + li) * MB_S + (kc * 32 + quad * 8) * 2);
#pragma unroll
                    for (int vt = 0; vt < 8; ++vt) O[vt] = (f32x4){0.f, 0.f, 0.f, 0.f};
                    dtot = 0.f;
                }
                const int qtok = qt * 128 + wave * 16 + li;
                const float bq = Bq[qtok];
                const bool diag = (qt == kt);
                f32x4 S[8];
#pragma unroll
                for (int st = 0; st < 8; ++st) {
                    f32x4 acc = (f32x4){0.f, 0.f, 0.f, 0.f};
#pragma unroll
                    for (int kc = 0; kc < 4; ++kc) {
                        const bf16x8 kf = *(const bf16x8*)(Kl + (st * 16 + li) * MB_S + (kc * 32 + quad * 8) * 2);
                        acc = __builtin_amdgcn_mfma_f32_16x16x32_bf16(kf, qf[kc], acc, 0, 0, 0);
                    }
                    S[st] = acc;
                }
                __builtin_amdgcn_sched_barrier(0);
                float dsum = 0.f;
#pragma unroll
                for (int st = 0; st < 8; ++st) {
                    const f32x4 g4 = *(const f32x4*)(Gk + kt * 128 + st * 16 + quad * 4);
#pragma unroll
                    for (int j = 0; j < 4; ++j) {
                        const int ktok = kt * 128 + st * 16 + quad * 4 + j;
                        const float pe = (!diag || ktok <= qtok) ? S[st][j] * (qscale * __expf(bq + g4[j])) : 0.f;
                        S[st][j] = pe; dsum += pe;
                    }
                }
                dsum += __shfl_xor(dsum, 16); dsum += __shfl_xor(dsum, 32);
                dtot += dsum;
                __builtin_amdgcn_sched_barrier(0);
#pragma unroll
                for (int c = 0; c < 4; ++c) {
                    u32x4 pw; pw.x = cvt_pk_bf16(S[2 * c][0], S[2 * c][1]); pw.y = cvt_pk_bf16(S[2 * c][2], S[2 * c][3]); pw.z = cvt_pk_bf16(S[2 * c + 1][0], S[2 * c + 1][1]); pw.w = cvt_pk_bf16(S[2 * c + 1][2], S[2 * c + 1][3]);
                    const bf16x8 pf = __builtin_bit_cast(bf16x8, pw);
#pragma unroll
                    for (int vt = 0; vt < 8; ++vt) {
                        const unsigned char* vp = VTl + (vt * 16 + li) * MB_S + (c * 32 + quad * 4) * 2;
                        const u32x2 lo = *(const u32x2*)vp, hi = *(const u32x2*)(vp + 32);
                        u32x4 vw; vw.x = lo.x; vw.y = lo.y; vw.z = hi.x; vw.w = hi.y;
                        O[vt] = __builtin_amdgcn_mfma_f32_16x16x32_bf16(__builtin_bit_cast(bf16x8, vw), pf, O[vt], 0, 0, 0);
                    }
                }
                __builtin_amdgcn_sched_barrier(0);
                if (qt == kt) {
                    float* np_ = NUML + (row0 + qtok) * 512 + h * 128 + quad * 4;
#pragma unroll
                    for (int vt = 0; vt < 8; ++vt) *(f32x4*)(np_ + vt * 16) = O[vt];
                    if (quad == 0) DENL[(row0 + qtok) * 4 + h] = dtot;
                }
            }
            __builtin_amdgcn_sched_barrier(0);
#pragma unroll 1
            for (int kc = 0; kc < 4; ++kc) {
                const f32x4 w0 = *(const f32x4*)(We + kt * 128 + kc * 32 + quad * 8), w1 = *(const f32x4*)(We + kt * 128 + kc * 32 + quad * 8 + 4);
                const unsigned char* kp = Kl + (kc * 32 + quad * 8) * MB_S + (wave * 16 + li) * 2;
                u32x4 kw;
                kw.x = cvt_pk_bf16(bf2f(*(const bf16_t*)(kp)) * w0[0], bf2f(*(const bf16_t*)(kp + MB_S)) * w0[1]);
                kw.y = cvt_pk_bf16(bf2f(*(const bf16_t*)(kp + 2 * MB_S)) * w0[2], bf2f(*(const bf16_t*)(kp + 3 * MB_S)) * w0[3]);
                kw.z = cvt_pk_bf16(bf2f(*(const bf16_t*)(kp + 4 * MB_S)) * w1[0], bf2f(*(const bf16_t*)(kp + 5 * MB_S)) * w1[1]);
                kw.w = cvt_pk_bf16(bf2f(*(const bf16_t*)(kp + 6 * MB_S)) * w1[2], bf2f(*(const bf16_t*)(kp + 7 * MB_S)) * w1[3]);
                const bf16x8 kfr = __builtin_bit_cast(bf16x8, kw);
#pragma unroll
                for (int vt = 0; vt < 8; ++vt) {
                    const bf16x8 vf = *(const bf16x8*)(VTl + (vt * 16 + li) * MB_S + (kc * 32 + quad * 8) * 2);
                    SC[vt] = __builtin_amdgcn_mfma_f32_16x16x32_bf16(vf, kfr, SC[vt], 0, 0, 0);
                }
            }
            {
                const int d = tid & 127, g = tid >> 7;
#pragma unroll 4
                for (int t = 0; t < 32; ++t) nacc += We[kt * 128 + g * 32 + t] * bf2f(*(const bf16_t*)(Kl + (g * 32 + t) * MB_S + d * 2));
            }
        }
#pragma unroll
        for (int vt = 0; vt < 8; ++vt)
#pragma unroll
            for (int j = 0; j < 4; ++j) ST[(size_t)w * 16384 + (vt * 16 + quad * 4 + j) * 128 + wave * 16 + li] = SC[vt][j];
        NR[(tid >> 7) * 128 + (tid & 127)] = nacc;
        __syncthreads();
        if (tid < 128) NS[w * 128 + tid] = (NR[tid] + NR[128 + tid]) + (NR[256 + tid] + NR[384 + tid]);
    }
}
template <bool HG> __device__ __forceinline__ float gatef_(float g) { const float s = sigmoidf_(g); return HG ? g * s : s; }
template <bool HG> __device__ __forceinline__ void phase_lin_C2(const Params& P, unsigned char* smem) {
    unsigned char* ws = P.ws;
    const bf16_t* __restrict__ PJ = (const bf16_t*)(ws + OFF_HP); bf16_t* __restrict__ Y = (bf16_t*)(ws + OFF_Y);
    const float* __restrict__ NUML = (const float*)(ws + OFF_OLOC); const float* __restrict__ DENL = (const float*)(ws + OFF_DENL); const float* __restrict__ CUMF = (const float*)(ws + OFF_CUMF);
    const float* __restrict__ ST = (const float*)(ws + OFF_ST); const float* __restrict__ NS = (const float*)(ws + OFF_NS);
    const int tid = ltid(), wave = tid >> 6, lane = tid & 63, li = lane & 15, quad = lane >> 4;
    unsigned char* CTl = smem; unsigned char* Ql = smem + 128 * MB_S; float* NP = (float*)(smem + 2 * 128 * MB_S);
    const float qscale = 0.08838834764831845f;
    const int sr = tid >> 4, sc16 = tid & 15;
    constexpr int LDP = HG ? NAB : NCD;
    const float* gain_ = HG ? P.hg_norm : P.ml_norm;
    for (int w = blockIdx.x; w < 256; w += gridDim.x) {
        const int b = w >> 7, h = (w >> 5) & 3, p = w & 31;
        const size_t row0 = (size_t)b * SEQ_ + p * 256;
        __syncthreads();
#pragma unroll
        for (int i = 0; i < 4; ++i) {
            const float* sp = ST + (size_t)w * 16384 + (sr + 32 * i) * 128 + sc16 * 8;
            const f32x4 a = *(const f32x4*)sp, c = *(const f32x4*)(sp + 4);
            u32x4 pw; pw.x = cvt_pk_bf16(a[0], a[1]); pw.y = cvt_pk_bf16(a[2], a[3]); pw.z = cvt_pk_bf16(c[0], c[1]); pw.w = cvt_pk_bf16(c[2], c[3]);
            *(u32x4*)(CTl + (sr + 32 * i) * MB_S + sc16 * 16) = pw;
        }
        if (!HG) { if (tid < 128) NP[tid] = NS[w * 128 + tid]; }
#pragma unroll 1
        for (int qt = 0; qt < 2; ++qt) {
            __syncthreads();
#pragma unroll
            for (int i = 0; i < 4; ++i) *(u32x4*)(Ql + (sr + 32 * i) * MB_S + sc16 * 16) = *(const u32x4*)(PJ + (row0 + qt * 128 + sr + 32 * i) * LDP + h * 128 + sc16 * 8);
            const size_t row = row0 + qt * 128 + wave * 16 + li;
            f32x4 nlv[8]; u32x2 gwv[8]; float cf_raw = 1.0f, den_raw = 0.f;
#pragma unroll
            for (int vt = 0; vt < 8; ++vt) { nlv[vt] = *(const f32x4*)(NUML + row * 512 + h * 128 + vt * 16 + quad * 4); gwv[vt] = *(const u32x2*)(PJ + row * LDP + 1536 + h * 128 + vt * 16 + quad * 4); }
            if (!HG) { cf_raw = CUMF[row * 4 + h]; den_raw = DENL[row * 4 + h]; }
            __syncthreads();
            bf16x8 qf[4];
#pragma unroll
            for (int kc = 0; kc < 4; ++kc) qf[kc] = *(const bf16x8*)(Ql + (wave * 16 + li) * MB_S + (kc * 32 + quad * 8) * 2);
            f32x4 O[8];
#pragma unroll
            for (int vt = 0; vt < 8; ++vt) {
                f32x4 acc = (f32x4){0.f, 0.f, 0.f, 0.f};
#pragma unroll
                for (int kc = 0; kc < 4; ++kc) {
                    const bf16x8 cf_ = *(const bf16x8*)(CTl + (vt * 16 + li) * MB_S + (kc * 32 + quad * 8) * 2);
                    acc = __builtin_amdgcn_mfma_f32_16x16x32_bf16(cf_, qf[kc], acc, 0, 0, 0);
                }
                O[vt] = acc;
            }
            float dc = 0.f;
            if (!HG) {
#pragma unroll
            for (int e = 0; e < 4; ++e) {
                const u32x4 qw = *(const u32x4*)(Ql + (wave * 16 + li) * MB_S + (quad * 32 + e * 8) * 2);
                const float* np_ = NP + quad * 32 + e * 8;
                dc += __uint_as_float(qw.x << 16) * np_[0] + __uint_as_float(qw.x & 0xFFFF0000u) * np_[1] + __uint_as_float(qw.y << 16) * np_[2] + __uint_as_float(qw.y & 0xFFFF0000u) * np_[3]
                    + __uint_as_float(qw.z << 16) * np_[4] + __uint_as_float(qw.z & 0xFFFF0000u) * np_[5] + __uint_as_float(qw.w << 16) * np_[6] + __uint_as_float(qw.w & 0xFFFF0000u) * np_[7];
            }
            dc += __shfl_xor(dc, 16); dc += __shfl_xor(dc, 32);
            }
            float cfq = 1.0f, invd = 1.0f;
            if (!HG) { cfq = cf_raw * qscale; const float den = den_raw + cfq * dc; invd = 1.0f / fmaxf(fabsf(den), 1.0f); }
            float ssq = 0.f;
#pragma unroll
            for (int vt = 0; vt < 8; ++vt) {
                const f32x4 nl = nlv[vt];
                const f32x4 hv = (nl + O[vt] * cfq) * invd;
                O[vt] = hv; ssq += (hv[0] * hv[0] + hv[1] * hv[1]) + (hv[2] * hv[2] + hv[3] * hv[3]);
            }
            ssq += __shfl_xor(ssq, 16); ssq += __shfl_xor(ssq, 32);
            const float rs = rsqrtf(ssq * (1.0f / 128.0f) + EPS_);
#pragma unroll
            for (int vt = 0; vt < 8; ++vt) {
                const int col = h * 128 + vt * 16 + quad * 4;
                const u32x2 gw = gwv[vt];
                const f32x4 gn = *(const f32x4*)(gain_ + col);
                const float y0 = O[vt][0] * rs * gn[0] * gatef_<HG>(__uint_as_float(gw.x << 16)), y1 = O[vt][1] * rs * gn[1] * gatef_<HG>(__uint_as_float(gw.x & 0xFFFF0000u));
                const float y2 = O[vt][2] * rs * gn[2] * gatef_<HG>(__uint_as_float(gw.y << 16)), y3 = O[vt][3] * rs * gn[3] * gatef_<HG>(__uint_as_float(gw.y & 0xFFFF0000u));
                u32x2 yw; yw.x = cvt_pk_bf16(y0, y1); yw.y = cvt_pk_bf16(y2, y3);
                *(u32x2*)(Y + row * D_ + col) = yw;
            }
        }
    }
}

constexpr int HG_S2 = 80;
constexpr int HG_OFF_Q = 0, HG_OFF_K = 32 * MB_S, HG_OFF_KT = 2 * 32 * MB_S, HG_OFF_VT = HG_OFF_KT + 128 * HG_S2, HG_OFF_SW = HG_OFF_VT + 128 * HG_S2, HG_OFF_TAB = HG_OFF_SW + 8 * 16 * MB_S;
__device__ __forceinline__ void phase_hgrn_A2(const Params& P, unsigned char* smem) {
    unsigned char* ws = P.ws;
    bf16_t* PJ = (bf16_t*)(ws + OFF_HP); const float* LB = (const float*)(ws + OFF_LB);
    float* OLOC = (float*)(ws + OFF_OLOC); float* ST = (float*)(ws + OFF_ST); float* DEC = (float*)(ws + OFF_DEC);
    const int tid = ltid(), wave = tid >> 6, lane = tid & 63, li = lane & 15, quad = lane >> 4;
    unsigned char* Ql = smem + HG_OFF_Q; unsigned char* Kl = smem + HG_OFF_K; unsigned char* KT2 = smem + HG_OFF_KT; unsigned char* VTl = smem + HG_OFF_VT;
    unsigned char* SWw = smem + HG_OFF_SW + wave * 16 * MB_S;
    float* Eend = (float*)(smem + HG_OFF_TAB); float* GT = Eend + 128;
    const int d = tid & 127, tg = tid >> 7;
    const int tr = tid & 31, tc16 = tid >> 5;
    for (int w = blockIdx.x; w < 256; w += gridDim.x) {
        const int b = w >> 7, h = (w >> 5) & 3, p = w & 31;
        const size_t row0 = (size_t)b * SEQ_ + p * 256;
        const float lbv = LB[h * 128 + d];
        float Bstart = 0.f;
        f32x4 SA[8];
#pragma unroll
        for (int dt = 0; dt < 8; ++dt) SA[dt] = (f32x4){0.f, 0.f, 0.f, 0.f};
        __syncthreads();
        for (int i = lane; i < 16 * MB_S / 16; i += 64) ((u32x4*)SWw)[i] = (u32x4){0u, 0u, 0u, 0u};
        asm volatile("s_waitcnt lgkmcnt(0)" ::: "memory");
        bf16_t rq[8], rf[8]; u32x4 rv;
        {
            const bf16_t* base = PJ + (row0 + tg * 8) * NAB + h * 128 + d;
#pragma unroll
            for (int e = 0; e < 8; ++e) { rq[e] = base[(size_t)e * NAB]; rf[e] = base[(size_t)e * NAB + 512]; }
            rv = *(const u32x4*)(PJ + (row0 + tr) * NAB + 1024 + h * 128 + tc16 * 8);
        }
#pragma unroll 1
        for (int c = 0; c < 8; ++c) {
            float qs[8], kk[8], cb[8]; float run = 0.f;
#pragma unroll
            for (int e = 0; e < 8; ++e) {
                const float f = lbv + (1.f - lbv) * sigmoidf_(bf2f(rf[e]));
                run += __logf(f); cb[e] = run; kk[e] = 1.f - f;
                const float q = bf2f(rq[e]); qs[e] = q * sigmoidf_(q);
            }
            lds_barrier();
            GT[tg * 128 + d] = run;
            {
                unsigned char* vp = VTl + (tc16 * 8) * HG_S2 + tr * 2;
                *(bf16_t*)(vp) = (bf16_t)(rv.x & 0xFFFFu); *(bf16_t*)(vp + HG_S2) = (bf16_t)(rv.x >> 16);
                *(bf16_t*)(vp + 2 * HG_S2) = (bf16_t)(rv.y & 0xFFFFu); *(bf16_t*)(vp + 3 * HG_S2) = (bf16_t)(rv.y >> 16);
                *(bf16_t*)(vp + 4 * HG_S2) = (bf16_t)(rv.z & 0xFFFFu); *(bf16_t*)(vp + 5 * HG_S2) = (bf16_t)(rv.z >> 16);
                *(bf16_t*)(vp + 6 * HG_S2) = (bf16_t)(rv.w & 0xFFFFu); *(bf16_t*)(vp + 7 * HG_S2) = (bf16_t)(rv.w >> 16);
            }
            lds_barrier();
            const float g0 = GT[d], g1 = GT[128 + d], g2 = GT[256 + d], g3 = GT[384 + d];
            const float pre = (tg > 0 ? g0 : 0.f) + (tg > 1 ? g1 : 0.f) + (tg > 2 ? g2 : 0.f), bend = (g0 + g1) + (g2 + g3);
            const size_t rsub = row0 + c * 32;
            const float ebend = __expf(bend), ebst = __expf(Bstart);
#pragma unroll
            for (int e = 0; e < 8; ++e) {
                const int t = tg * 8 + e; const float bt = pre + cb[e];
                const float ep = __expf(bt), en = __expf(-bt);
                const float qd = qs[e] * ep, kd = kk[e] * en;
                *(bf16_t*)(Ql + t * MB_S + d * 2) = f2bf(qd);
                *(bf16_t*)(Kl + t * MB_S + d * 2) = f2bf(kd);
                *(bf16_t*)(KT2 + d * HG_S2 + t * 2) = f2bf(kd * ebend);
                PJ[(rsub + t) * NAB + h * 128 + d] = f2bf(qd * ebst);
            }
            if (tg == 0) Eend[d] = ebend;
            Bstart += bend;
            if (c < 7) {
                const bf16_t* base = PJ + (rsub + 32 + tg * 8) * NAB + h * 128 + d;
#pragma unroll
                for (int e = 0; e < 8; ++e) { rq[e] = base[(size_t)e * NAB]; rf[e] = base[(size_t)e * NAB + 512]; }
                rv = *(const u32x4*)(PJ + (rsub + 32 + tr) * NAB + 1024 + h * 128 + tc16 * 8);
            }
            lds_barrier();
            bf16x8 qf[2][4];
#pragma unroll
            for (int qt = 0; qt < 2; ++qt)
#pragma unroll
                for (int kc = 0; kc < 4; ++kc) qf[qt][kc] = *(const bf16x8*)(Ql + (qt * 16 + li) * MB_S + (kc * 32 + quad * 8) * 2);
            f32x4 S00 = (f32x4){0.f, 0.f, 0.f, 0.f}, S01 = S00, S11 = S00;
#pragma unroll
            for (int kc = 0; kc < 4; ++kc) {
                const bf16x8 k0 = *(const bf16x8*)(Kl + li * MB_S + (kc * 32 + quad * 8) * 2), k1 = *(const bf16x8*)(Kl + (16 + li) * MB_S + (kc * 32 + quad * 8) * 2);
                S00 = __builtin_amdgcn_mfma_f32_16x16x32_bf16(k0, qf[0][kc], S00, 0, 0, 0);
                S01 = __builtin_amdgcn_mfma_f32_16x16x32_bf16(k0, qf[1][kc], S01, 0, 0, 0);
                S11 = __builtin_amdgcn_mfma_f32_16x16x32_bf16(k1, qf[1][kc], S11, 0, 0, 0);
            }
#pragma unroll
            for (int j = 0; j < 4; ++j) { const bool ok = (quad * 4 + j) <= li; S00[j] = ok ? S00[j] : 0.f; S11[j] = ok ? S11[j] : 0.f; }
            u32x4 pw0, pw1;
            pw0.x = cvt_pk_bf16(S00[0], S00[1]); pw0.y = cvt_pk_bf16(S00[2], S00[3]); pw0.z = 0u; pw0.w = 0u;
            pw1.x = cvt_pk_bf16(S01[0], S01[1]); pw1.y = cvt_pk_bf16(S01[2], S01[3]); pw1.z = cvt_pk_bf16(S11[0], S11[1]); pw1.w = cvt_pk_bf16(S11[2], S11[3]);
            const unsigned char* vrow = VTl + (wave * 16 + li) * HG_S2;
            u32x4 vwi; { const u32x2 lo = *(const u32x2*)(vrow + quad * 8), hi = *(const u32x2*)(vrow + 32 + quad * 8); vwi.x = lo.x; vwi.y = lo.y; vwi.z = hi.x; vwi.w = hi.y; }
            const bf16x8 vfi = __builtin_bit_cast(bf16x8, vwi);
#pragma unroll
            for (int qt = 0; qt < 2; ++qt) {
                f32x4 O = (f32x4){0.f, 0.f, 0.f, 0.f};
#pragma unroll
                for (int kc = 0; kc < 4; ++kc) {
                    const bf16x8 sf = *(const bf16x8*)(SWw + li * MB_S + (kc * 32 + quad * 8) * 2);
                    O = __builtin_amdgcn_mfma_f32_16x16x32_bf16(sf, qf[qt][kc], O, 0, 0, 0);
                }
                O = __builtin_amdgcn_mfma_f32_16x16x32_bf16(vfi, __builtin_bit_cast(bf16x8, qt ? pw1 : pw0), O, 0, 0, 0);
                *(f32x4*)(OLOC + (rsub + qt * 16 + li) * 512 + h * 128 + wave * 16 + quad * 4) = O;
            }
            const bf16x8 vfa = *(const bf16x8*)(vrow + quad * 16);
#pragma unroll
            for (int dt = 0; dt < 8; ++dt) {
                const bf16x8 k2f = *(const bf16x8*)(KT2 + (dt * 16 + li) * HG_S2 + quad * 16);
                const float ee = Eend[dt * 16 + li];
                SA[dt] = __builtin_amdgcn_mfma_f32_16x16x32_bf16(vfa, k2f, SA[dt] * ee, 0, 0, 0);
            }
            asm volatile("s_waitcnt lgkmcnt(0)" ::: "memory");
#pragma unroll
            for (int dt = 0; dt < 8; ++dt)
#pragma unroll
                for (int j = 0; j < 4; ++j) *(bf16_t*)(SWw + (quad * 4 + j) * MB_S + (dt * 16 + li) * 2) = f2bf(SA[dt][j]);
            asm volatile("s_waitcnt lgkmcnt(0)" ::: "memory");
        }
#pragma unroll
        for (int dt = 0; dt < 8; ++dt)
#pragma unroll
            for (int j = 0; j < 4; ++j) ST[(size_t)w * 16384 + (wave * 16 + quad * 4 + j) * 128 + dt * 16 + li] = SA[dt][j];
        if (tg == 0) DEC[w * 128 + d] = __expf(Bstart);
    }
}

__device__ __forceinline__ void phase_final(const Params& P) {
    const float* SS = (const float*)(P.ws + OFF_SS);
    const int wave = ltid() >> 6, lane = ltid() & 63;
    const f32x4* gr = (const f32x4*)P.final_norm;
    f32x4 g[4];
#pragma unroll
    for (int i = 0; i < 4; ++i) g[i] = gr[lane + 64 * i];
    for (int row = (blockIdx.x * 8 + wave) * 2; row < M_; row += gridDim.x * 16) {
        const float rs0 = row_rstd(SS, row), rs1 = row_rstd(SS, row + 1);
        f32x4* x0 = (f32x4*)(P.out + (size_t)row * D_); f32x4* x1 = x0 + D_ / 4;
        f32x4 v0[4], v1[4];
#pragma unroll
        for (int i = 0; i < 4; ++i) { v0[i] = x0[lane + 64 * i]; v1[i] = x1[lane + 64 * i]; }
#pragma unroll
        for (int i = 0; i < 4; ++i) { x0[lane + 64 * i] = v0[i] * rs0 * g[i]; x1[lane + 64 * i] = v1[i] * rs1 * g[i]; }
    }
}

#define XB_TMO      128
#define XB_XCNT(j)  (256  + 64 * (j))
#define XB_XSUB(j)  (1280 + 64 * (j))
#define XB_XGEN(j)  (2304 + 64 * (j))
#define XB_TOP      3328
#define XB_TOPGEN   3392
#define XCD_BAR_WORDS 3456
#define XB_SPIN_CAP (1u << 18)
__device__ __forceinline__ unsigned xb_ld(unsigned* p)              { return __hip_atomic_load(p, __ATOMIC_RELAXED, __HIP_MEMORY_SCOPE_AGENT); }
__device__ __forceinline__ unsigned xb_add(unsigned* p, unsigned v) { return __hip_atomic_fetch_add(p, v, __ATOMIC_RELAXED, __HIP_MEMORY_SCOPE_AGENT); }
__device__ __forceinline__ unsigned xb_xcc_id() { return (unsigned)__builtin_amdgcn_s_getreg((3 << 11) | 20) & 0xFu; }
#define XB_SPIN(cond, bar) do { unsigned _sp = 0; while (cond) { __builtin_amdgcn_s_sleep(1); \
    if ((++_sp & 255u) == 0u) { if (xb_ld(&(bar)[XB_TMO])) break; if (_sp > XB_SPIN_CAP) { atomicAdd(&(bar)[XB_TMO], 1u); break; } } } } while (0)
struct XcdBarrier { unsigned* bar; unsigned x; volatile LAS unsigned* st; };
__device__ __forceinline__ XcdBarrier xcd_barrier_post(unsigned* bar, volatile LAS unsigned* st) {
    XcdBarrier b; b.bar = bar; b.x = xb_xcc_id(); b.st = st;
    if (threadIdx.x == 0) (void)xb_add(&bar[XB_XCNT(b.x)], 1u);
    return b;
}
__device__ __forceinline__ void xcd_barrier_complete(unsigned* bar, unsigned x, unsigned& nloc, unsigned& nx) {
    const unsigned G = gridDim.x * gridDim.y * gridDim.z;
    unsigned sum, cnt, mine, sp = 0u;
    for (;;) {
        sum = 0u; cnt = 0u; mine = 0u;
#pragma unroll
        for (unsigned j = 0; j < 16; ++j) { const unsigned c = xb_ld(&bar[XB_XCNT(j)]); sum += c; cnt += (c > 0u) ? 1u : 0u; mine = (j == x) ? c : mine; }
        if (sum == G) break;
        __builtin_amdgcn_s_sleep(1);
        if ((++sp & 255u) == 0u) { if (xb_ld(&bar[XB_TMO])) break; if (sp > XB_SPIN_CAP) { atomicAdd(&bar[XB_TMO], 1u); break; } }
    }
    nloc = mine > 0u ? mine : 1u; nx = cnt > 0u ? cnt : 1u;
}
__device__ __forceinline__ void xcd_barrier(const XcdBarrier& b) {
    asm volatile("s_waitcnt vmcnt(0)" ::: "memory");
    __syncthreads();
    if (threadIdx.x == 0) {
        unsigned* bar = b.bar;
        __builtin_amdgcn_s_waitcnt(0);
        unsigned nloc = b.st[0], nx = b.st[1];
        if (nloc == 0u) { xcd_barrier_complete(bar, b.x, nloc, nx); b.st[0] = nloc; b.st[1] = nx; }
        const unsigned old = xb_add(&bar[XB_XSUB(b.x)], 1u);
        const unsigned gen = old / nloc;
        if (old + 1u == (gen + 1u) * nloc) {
            __builtin_amdgcn_fence(__ATOMIC_RELEASE, "agent");
            asm volatile("s_waitcnt vmcnt(0)" ::: "memory");
            const unsigned og = xb_add(&bar[XB_TOP], 1u);
            const unsigned tg = og / nx;
            if (og + 1u == (tg + 1u) * nx) xb_add(&bar[XB_TOPGEN], 1u);
            else XB_SPIN(xb_ld(&bar[XB_TOPGEN]) == tg, bar);
            __builtin_amdgcn_fence(__ATOMIC_ACQUIRE, "agent");
            xb_add(&bar[XB_XGEN(b.x)], 1u);
            asm volatile("s_waitcnt vmcnt(0)" ::: "memory");
        } else {
            XB_SPIN(xb_ld(&bar[XB_XGEN(b.x)]) == gen, bar);
            __builtin_amdgcn_fence(__ATOMIC_ACQUIRE, "agent");
            asm volatile("s_waitcnt vmcnt(0)" ::: "memory");
        }
    }
    __syncthreads();
}

constexpr int N_PHASES = 20;
__global__ void __launch_bounds__(512, 2) mk_fwd(Params P0_, int ph_lo, int ph_hi) {
    extern __shared__ __attribute__((aligned(16))) unsigned char smem[];
    LAS unsigned char* lds = (LAS unsigned char*)smem;
    float* L = (float*)smem;
    XcdBarrier xbar; xbar.bar = (unsigned*)(P0_.ws + OFF_BAR); xbar.x = 0; xbar.st = (volatile LAS unsigned*)(lds + LDS_MISC_OFF);
    if (ph_hi - ph_lo > 1) {
        if (threadIdx.x < 2) xbar.st[threadIdx.x] = 0u;
        if (blockIdx.x == 0) { u32x4* bw = (u32x4*)(P0_.ws + OFF_BAR); for (int i = threadIdx.x; i < 16384 / 16; i += 512) bw[i] = (u32x4){0u, 0u, 0u, 0u}; }
        __syncthreads();
    }
    for (int ph = ph_lo; ph < ph_hi; ++ph) {
        Params P = P0_;
        { size_t z_ = 0; asm volatile("" : "+s"(z_));
#define LAUNDER(f) P.f = P0_.f + z_
        LAUNDER(x); LAUNDER(ffn_norm); LAUNDER(ffn_w_in); LAUNDER(ffn_w_out); LAUNDER(mix_norm); LAUNDER(ab_w_in); LAUNDER(ab_w_out); LAUNDER(lb_logits); LAUNDER(hg_norm);
        LAUNDER(conv_w); LAUNDER(conv_b); LAUNDER(cd_w_in); LAUNDER(cd_w_out); LAUNDER(gate_bias); LAUNDER(ml_norm); LAUNDER(final_norm); LAUNDER(out); LAUNDER(ws);
#undef LAUNDER
        }
        unsigned char* ws = P.ws;
        bf16_t* XB = (bf16_t*)(ws + OFF_XB); float* SS = (float*)(ws + OFF_SS); bf16_t* HP = (bf16_t*)(ws + OFF_HP); bf16_t* Y = (bf16_t*)(ws + OFF_Y);
        int kind = -1, widx = 0;
        switch (ph) {
            case 1: kind = 0; widx = 0; break;  case 2: kind = 1; widx = 0; break;
            case 3: kind = 2; widx = 0; break;  case 7: kind = 3; widx = 0; break;
            case 8: kind = 0; widx = 1; break;  case 9: kind = 1; widx = 1; break;
            case 10: kind = 0; widx = 2; break; case 11: kind = 1; widx = 2; break;
            case 12: kind = 2; widx = 1; break; case 16: kind = 3; widx = 1; break;
            case 17: kind = 0; widx = 3; break; case 18: kind = 1; widx = 3; break;
            default: break;
        }
        if (kind == 0) {
            EpiSwiglu E{HP, (const float*)(ws + OFF_RS)};
            run_gemm<EpiSwiglu>(lds, XB, (const bf16_t*)(ws + OFF_W1T + widx * SZ_W1T), NFF1, D_, E, SS, (float*)(ws + OFF_RS), P, smem, ph == 1 ? 1 : (ph == 8 ? 3 : (ph == 10 ? 4 : 0)));
        } else if (kind == 1 || kind == 3) {
            const float* xin = (ph == 2) ? P.x : P.out;
            EpiResid E{xin, P.out, XB, SS, kind == 1 ? 0.5f : 1.0f, ph == 18 ? 0 : 1};
            const bf16_t* A = (kind == 1) ? HP : Y;
            const bf16_t* Bt = (kind == 1) ? (const bf16_t*)(ws + OFF_W2T + widx * SZ_W2T) : (const bf16_t*)(ws + (widx == 0 ? OFF_ABOUT : OFF_CDOUT));
            run_gemm<EpiResid>(lds, A, Bt, D_, kind == 1 ? FF_ : D_, E, nullptr, nullptr, P, smem, 0);
        } else if (kind == 2) {
            EpiProj E{HP, widx == 0 ? NAB : NCD, (const float*)(ws + OFF_RS), widx == 0 ? nullptr : (float*)(ws + OFF_GATES), 3584};
            run_gemm<EpiProj>(lds, XB, (const bf16_t*)(ws + (widx == 0 ? OFF_ABIN : OFF_CDIN)), widx == 0 ? NAB : NCD, D_, E, SS, (float*)(ws + OFF_RS), P, smem, widx == 0 ? 2 : 0);
        } else {
            switch (ph) {
                case 0: phase_prologue(P, L); break;
                case 4: phase_hgrn_A2(P, smem); break;
                case 5: phase_scan((float*)(ws + OFF_ST), (const float*)(ws + OFF_DEC), 1); phase_conv(P); break;
                case 6: phase_lin_C2<true>(P, smem); break;
                case 13: phase_moba_pre(P, L); phase_mlstm_A2(P, smem); break;
                case 14: phase_scan((float*)(ws + OFF_ST), (const float*)(ws + OFF_DSEG), 0); phase_scan_n((float*)(ws + OFF_NS), (const float*)(ws + OFF_DSEG)); __syncthreads(); phase_moba_attn_mfma(P, smem); break;
                case 15: phase_lin_C2<false>(P, smem); break;
                case 19: phase_final(P); break;
                default: break;
            }
        }
        if (ph + 1 < ph_hi) {
            if (ph == 0) { cg::this_grid().sync(); xbar = xcd_barrier_post((unsigned*)(P0_.ws + OFF_BAR), (volatile LAS unsigned*)(lds + LDS_MISC_OFF)); }
            else xcd_barrier(xbar);
        }
    }
}

extern "C" void kernel_launch(void* const* d_in, const int* in_sizes, int n_in, void* d_out, int out_size, void* d_ws, size_t ws_size, hipStream_t stream) {
    static int grid = 0;
    constexpr int LDS_BYTES = LDS_TOTAL;
    if (grid == 0) {
        if (n_in != 16 || in_sizes[0] != M_ * D_ || out_size != M_ * D_ || ws_size < WS_END) { fprintf(stderr, "kernel_launch: unexpected shapes/workspace (n_in %d, ws %zu, need %zu)\n", n_in, ws_size, (size_t)WS_END); grid = -1; return; }
        int dev = 0, cus = 0, per_cu = 0;
        hipGetDevice(&dev); hipDeviceGetAttribute(&cus, hipDeviceAttributeMultiprocessorCount, dev);
        if (hipFuncSetAttribute((const void*)mk_fwd, hipFuncAttributeMaxDynamicSharedMemorySize, LDS_BYTES) != hipSuccess) { fprintf(stderr, "kernel_launch: hipFuncSetAttribute failed\n"); grid = -1; return; }
        if (hipOccupancyMaxActiveBlocksPerMultiprocessor(&per_cu, (const void*)mk_fwd, 512, LDS_BYTES) != hipSuccess || per_cu < 1) { fprintf(stderr, "kernel_launch: occupancy query failed (%d)\n", per_cu); per_cu = 1; }
        (void)hipGetLastError();
        grid = cus * (per_cu > 1 ? 1 : per_cu);
    }
    if (grid < 0) return;
    Params p{};
    p.x = (const float*)d_in[0]; p.ffn_norm = (const float*)d_in[1]; p.ffn_w_in = (const float*)d_in[2]; p.ffn_w_out = (const float*)d_in[3]; p.mix_norm = (const float*)d_in[4];
    p.ab_w_in = (const float*)d_in[5]; p.ab_w_out = (const float*)d_in[6]; p.lb_logits = (const float*)d_in[7]; p.hg_norm = (const float*)d_in[8]; p.conv_w = (const float*)d_in[9]; p.conv_b = (const float*)d_in[10];
    p.cd_w_in = (const float*)d_in[11]; p.cd_w_out = (const float*)d_in[12]; p.gate_bias = (const float*)d_in[13]; p.ml_norm = (const float*)d_in[14]; p.final_norm = (const float*)d_in[15];
    p.out = (float*)d_out; p.ws = (unsigned char*)d_ws;
#if N_LAUNCH_MODE == 1
    int lo = 0, hi = N_PHASES;
    void* args[] = {&p, &lo, &hi};
    hipError_t e = hipLaunchCooperativeKernel((const void*)mk_fwd, dim3(grid), dim3(512), args, LDS_BYTES, stream);
    if (e != hipSuccess) fprintf(stderr, "cooperative launch failed: %s (grid %d)\n", hipGetErrorString(e), grid);
#else
    for (int ph = 0; ph < N_PHASES; ++ph) {
        hipLaunchKernelGGL(mk_fwd, dim3(grid), dim3(512), LDS_BYTES, stream, p, ph, ph + 1);
    }
#endif
}
```

```cpp
#include <hip/hip_runtime.h>
#include <hip/hip_cooperative_groups.h>
#include <cstdio>
#include <cstdint>
namespace cg = cooperative_groups;

#ifndef N_LAUNCH_MODE
#define N_LAUNCH_MODE 1
#endif

#define LAS __attribute__((address_space(3)))
typedef unsigned short bf16_t;
typedef short bf16x8 __attribute__((ext_vector_type(8)));
typedef float f32x4 __attribute__((ext_vector_type(4)));
typedef unsigned u32x4 __attribute__((ext_vector_type(4)));
typedef unsigned u32x2 __attribute__((ext_vector_type(2)));

constexpr int M_ = 16384, D_ = 1024, FF_ = 2816, NFF1 = 5632, NAB = 3584, NCD = 3840, SEQ_ = 8192;
constexpr float EPS_ = 1e-6f;

constexpr size_t SZ_W1T = (size_t)NFF1 * D_ * 2, SZ_W2T = (size_t)D_ * FF_ * 2;
constexpr size_t OFF_W1T = 0;
constexpr size_t OFF_W2T = OFF_W1T + 4 * SZ_W1T;
constexpr size_t OFF_ABIN = OFF_W2T + 4 * SZ_W2T;
constexpr size_t OFF_ABOUT = OFF_ABIN + (size_t)NAB * D_ * 2;
constexpr size_t OFF_CDIN = OFF_ABOUT + (size_t)D_ * D_ * 2;
constexpr size_t OFF_CDOUT = OFF_CDIN + (size_t)NCD * D_ * 2;
constexpr size_t OFF_XB = OFF_CDOUT + (size_t)D_ * D_ * 2;
constexpr size_t OFF_SS = OFF_XB + (size_t)M_ * D_ * 2;
constexpr size_t OFF_GATES = OFF_SS + (size_t)M_ * 16 * 4;
constexpr size_t OFF_HP = OFF_GATES + (size_t)M_ * 8 * 4;
constexpr size_t OFF_Y = OFF_HP + (size_t)M_ * NCD * 2;
constexpr size_t OFF_OLOC = OFF_Y + (size_t)M_ * D_ * 2;
constexpr size_t OFF_ST = OFF_OLOC + (size_t)M_ * 512 * 4;
constexpr size_t OFF_DEC = OFF_ST + (size_t)256 * 16384 * 4;
constexpr size_t OFF_NS = OFF_DEC + (size_t)256 * 128 * 4;
constexpr size_t OFF_DENL = OFF_NS + (size_t)256 * 128 * 4;
constexpr size_t OFF_CUMF = OFF_DENL + (size_t)M_ * 4 * 4;
constexpr size_t OFF_DSEG = OFF_CUMF + (size_t)M_ * 4 * 4;
constexpr size_t OFF_KMEAN = OFF_DSEG + 1024;
constexpr size_t OFF_LB = OFF_KMEAN + (size_t)2 * 4 * 32 * 128 * 4;
constexpr size_t OFF_RS = OFF_LB + 2048;
constexpr size_t OFF_BAR = OFF_RS + (size_t)M_ * 4;
constexpr size_t WS_END = OFF_BAR + 16384;

struct Params {
    const float* x; const float* ffn_norm; const float* ffn_w_in; const float* ffn_w_out; const float* mix_norm;
    const float* ab_w_in; const float* ab_w_out; const float* lb_logits; const float* hg_norm; const float* conv_w; const float* conv_b;
    const float* cd_w_in; const float* cd_w_out; const float* gate_bias; const float* ml_norm; const float* final_norm;
    float* out; unsigned char* ws;
};

__device__ __forceinline__ int ltid() { int t = (int)threadIdx.x; asm volatile("" : "+v"(t)); return t; }
__device__ __forceinline__ float bf2f(unsigned short b) { return __uint_as_float(((unsigned)b) << 16); }
typedef float f32x2_t __attribute__((ext_vector_type(2)));
typedef __bf16 bf16x2_t __attribute__((ext_vector_type(2)));
__device__ __forceinline__ unsigned cvt_pk_bf16(float lo, float hi) { f32x2_t v = {lo, hi}; bf16x2_t b = __builtin_convertvector(v, bf16x2_t); return __builtin_bit_cast(unsigned, b); }
__device__ __forceinline__ unsigned short f2bf(float f) { return (unsigned short)(cvt_pk_bf16(f, 0.f) & 0xFFFFu); }
__device__ __forceinline__ unsigned pk2(float lo, float hi) { return cvt_pk_bf16(lo, hi); }
__device__ __forceinline__ float sigmoidf_(float x) { return __builtin_amdgcn_rcpf(1.0f + __expf(-x)); }
__device__ __forceinline__ void lds_barrier() { asm volatile("s_waitcnt lgkmcnt(0)" ::: "memory"); __builtin_amdgcn_s_barrier(); asm volatile("" ::: "memory"); }
__device__ __forceinline__ float wave_sum(float v) {
#pragma unroll
    for (int o = 32; o >= 1; o >>= 1) v += __shfl_xor(v, o);
    return v;
}
__device__ __forceinline__ float wave_max(float v) {
#pragma unroll
    for (int o = 32; o >= 1; o >>= 1) v = fmaxf(v, __shfl_xor(v, o));
    return v;
}

namespace pg8 {
constexpr int BM = 256, BK = 64, HALF = 128, HTB = HALF * BK * 2, STAGE_BYTES = 8 * HTB, NXCD = 8, WGM = 4;
__host__ __device__ __forceinline__ int lds_byte(int r, int c) { const int st = (r >> 4) * 2 + (c >> 5), rr = r & 15, cc = c & 31, ob = rr * 64 + cc * 2; return st * 1024 + (ob ^ (((ob >> 9) & 1) << 5)); }
__host__ __device__ __forceinline__ void stage_rc(int b, int& R, int& C) { const int st = b / 1024, sb = b % 1024, swz = sb ^ (((sb >> 9) & 1) << 5); R = (st >> 1) * 16 + swz / 64; C = (st & 1) * 32 + (swz % 64) / 2; }
__host__ __device__ __forceinline__ int perm32(int rho) { const int n = rho >> 4, i = rho & 15; return 8 * (i >> 2) + 4 * n + (i & 3); }
struct Unit { int pm, pn; };
struct Gemm { const bf16_t* A; const bf16_t* Bt; int M, N, K; };
struct StaticOrder {
    int nM, nN, nwg, G, c;
    __host__ __device__ void init(int M, int N, int G_, int c_) { nM = M / BM; nN = N / BM; nwg = nM * nN; G = G_; c = c_; }
    __host__ __device__ bool next(int i, Unit& u) const {
        const long L = (long)i * G + c; if (L >= nwg) return false;
        int wgid = (int)L; { const int q = nwg / NXCD, r = nwg % NXCD, xcd = wgid % NXCD, off = wgid / NXCD; wgid = (xcd < r ? xcd * (q + 1) : r * (q + 1) + (xcd - r) * q) + off; }
        const int nig = WGM * nN, gid = wgid / nig, fm = gid * WGM, gsz = (nM - fm) < WGM ? (nM - fm) : WGM;
        u.pm = fm + ((wgid % nig) % gsz); u.pn = (wgid % nig) / gsz; return true;
    }
};

template <class Epi>
__device__ __forceinline__ void gemm_phase(LAS unsigned char* lds, const Gemm g, const StaticOrder& S, const Epi& E) {
    const int tid = ltid(), wid = __builtin_amdgcn_readfirstlane(tid >> 6), lane = tid & 63, wr = wid >> 2, wc = wid & 3, fr = lane & 15, fq = lane >> 4;
    const int K = g.K, nt = K / BK;
    unsigned voffA[2], voffB[2];
#pragma unroll
    for (int i = 0; i < 2; ++i) { int R, C; stage_rc(tid * 16 + i * 8192, R, C); const int Rb = ((R & ~31) + perm32(R & 31));
        voffA[i] = (unsigned)(R * K + C) * 2u; voffB[i] = (unsigned)(Rb * K + C) * 2u; }
    const size_t kstep = (size_t)(BK * 2);
    const size_t hstep = (size_t)HALF * K * 2;
    const size_t tstep = 2 * hstep;
    const unsigned ldsw = (unsigned)wid * 1024u;
    const int aoff = lds_byte(wr * 64 + fr, fq * 8), boff = lds_byte(wc * 32 + fr, fq * 8);
#define PG8_SA(b, h) (((b) * 2 + (h)) * HTB)
#define PG8_SB(b, h) ((4 + (b) * 2 + (h)) * HTB)
#define PG8_STAGE(bufoff, gbase, voff) do { _Pragma("unroll") for (int _i = 0; _i < 2; ++_i) \
        __builtin_amdgcn_global_load_lds((const unsigned*)((const char*)(gbase) + (voff)[_i]), (LAS unsigned*)(lds + (bufoff) + ldsw + _i * 8192), 16, 0, 0); } while (0)
#define PG8_LDA(dst, b, h) do { _Pragma("unroll") for (int m = 0; m < 4; ++m) _Pragma("unroll") for (int k = 0; k < 2; ++k) dst[m][k] = *(const LAS bf16x8*)(lds + PG8_SA(b, h) + aoff + m * 2048 + k * 1024); } while (0)
#define PG8_LDB(dst, b, h) do { _Pragma("unroll") for (int n = 0; n < 2; ++n) _Pragma("unroll") for (int k = 0; k < 2; ++k) dst[n][k] = *(const LAS bf16x8*)(lds + PG8_SB(b, h) + boff + n * 2048 + k * 1024); } while (0)
#define PG8_MMA(ai, bj, At, Bt) do { __builtin_amdgcn_s_setprio(1); _Pragma("unroll") for (int m = 0; m < 4; ++m) _Pragma("unroll") for (int n = 0; n < 2; ++n) _Pragma("unroll") for (int k = 0; k < 2; ++k) \
        acc[ai][bj][m][n] = __builtin_amdgcn_mfma_f32_16x16x32_bf16(Bt[n][k], At[m][k], acc[ai][bj][m][n], 0, 0, 0); __builtin_amdgcn_s_setprio(0); } while (0)
#define PG8_WAIT_V(n) asm volatile("s_waitcnt vmcnt(" #n ")" ::: "memory")
#define PG8_WAIT_L(n) asm volatile("s_waitcnt lgkmcnt(" #n ")" ::: "memory")
#define PG8_BAR __builtin_amdgcn_s_barrier()
#define PG8_SCHED __builtin_amdgcn_sched_barrier(0)
    Unit cur, nxt; int ui = 0;
    if (!S.next(0, cur)) return;
    f32x4 acc[2][2][4][2];
#pragma unroll
    for (int a = 0; a < 2; ++a)
#pragma unroll
        for (int b = 0; b < 2; ++b)
#pragma unroll
            for (int m = 0; m < 4; ++m)
#pragma unroll
                for (int n = 0; n < 2; ++n) acc[a][b][m][n] = (f32x4){0.f, 0.f, 0.f, 0.f};
    bf16x8 At[4][2], B0[2][2], B1[2][2];
    const char* cA = (const char*)g.A + (size_t)cur.pm * tstep; const char* cB = (const char*)g.Bt + (size_t)cur.pn * tstep;
    typename Epi::Pre epre = E.prefetch(cur, wr, fr);
    PG8_STAGE(PG8_SB(0, 0), cB, voffB); PG8_STAGE(PG8_SB(0, 1), cB + hstep, voffB); PG8_STAGE(PG8_SA(0, 0), cA, voffA); PG8_STAGE(PG8_SA(0, 1), cA + hstep, voffA);
    if (wr == 1) PG8_BAR;
    PG8_WAIT_V(2); PG8_BAR;
    PG8_STAGE(PG8_SB(1, 0), cB + kstep, voffB); PG8_STAGE(PG8_SA(1, 0), cA + kstep, voffA); PG8_STAGE(PG8_SB(1, 1), cB + hstep + kstep, voffB);
    PG8_WAIT_V(6); PG8_BAR;
    for (;;) {
        const bool has_next = S.next(ui + 1, nxt);
        const char* nA = has_next ? (const char*)g.A + (size_t)nxt.pm * tstep : cA; const char* nB = has_next ? (const char*)g.Bt + (size_t)nxt.pn * tstep : cB;
        for (int t = 0; t < nt; t += 2) {
            const bool last = (t == nt - 2);
            const char* a1 = cA + (size_t)(t + 1) * kstep;
            const char* a2 = last ? nA : cA + (size_t)(t + 2) * kstep; const char* b2 = last ? nB : cB + (size_t)(t + 2) * kstep;
            const char* a3 = a2 + kstep; const char* b3 = b2 + kstep;
            PG8_LDB(B0, 0, 0); PG8_LDB(B1, 0, 1); PG8_SCHED; PG8_LDA(At, 0, 0); PG8_STAGE(PG8_SA(1, 1), a1 + hstep, voffA);
            PG8_WAIT_V(8); PG8_WAIT_L(0); PG8_BAR; PG8_MMA(0, 0, At, B0); PG8_MMA(0, 1, At, B1); PG8_BAR; PG8_SCHED;
            PG8_LDA(At, 0, 1); PG8_STAGE(PG8_SB(0, 0), b2, voffB); PG8_STAGE(PG8_SB(0, 1), b2 + hstep, voffB); PG8_STAGE(PG8_SA(0, 0), a2, voffA);
            PG8_WAIT_V(8); PG8_WAIT_L(0); PG8_BAR; PG8_MMA(1, 0, At, B0); PG8_MMA(1, 1, At, B1); PG8_BAR; PG8_SCHED;
            PG8_LDB(B0, 1, 0); PG8_LDB(B1, 1, 1); PG8_SCHED; PG8_LDA(At, 1, 0); PG8_STAGE(PG8_SA(0, 1), a2 + hstep, voffA);
            PG8_WAIT_V(8); PG8_WAIT_L(0); PG8_BAR; PG8_MMA(0, 0, At, B0); PG8_MMA(0, 1, At, B1); PG8_BAR; PG8_SCHED;
            PG8_LDA(At, 1, 1); PG8_STAGE(PG8_SB(1, 0), b3, voffB); PG8_STAGE(PG8_SB(1, 1), b3 + hstep, voffB); PG8_STAGE(PG8_SA(1, 0), a3, voffA);
            PG8_WAIT_V(8); PG8_WAIT_L(0); PG8_BAR; PG8_MMA(1, 0, At, B0); PG8_MMA(1, 1, At, B1); PG8_BAR; PG8_SCHED;
        }
        if (wr == 0) PG8_BAR;
        E(acc, cur, wr, wc, fr, fq, epre);
        if (!has_next) break;
#pragma unroll
        for (int a = 0; a < 2; ++a)
#pragma unroll
            for (int b = 0; b < 2; ++b)
#pragma unroll
                for (int m = 0; m < 4; ++m)
#pragma unroll
                    for (int n = 0; n < 2; ++n) acc[a][b][m][n] = (f32x4){0.f, 0.f, 0.f, 0.f};
        cur = nxt; cA = nA; cB = nB; ++ui;
        epre = E.prefetch(cur, wr, fr);
        if (wr == 1) PG8_BAR;
    }
    PG8_WAIT_V(0);
    PG8_BAR;
#undef PG8_SA
#undef PG8_SB
#undef PG8_STAGE
#undef PG8_LDA
#undef PG8_LDB
#undef PG8_MMA
#undef PG8_WAIT_V
#undef PG8_WAIT_L
#undef PG8_BAR
#undef PG8_SCHED
}
}

__device__ __forceinline__ float row_rstd(const float* ss, int row) {
    const f32x4* sp = (const f32x4*)(ss + (size_t)row * 16);
    const f32x4 a = sp[0], b = sp[1], c = sp[2], d = sp[3];
    const float s = ((a[0] + a[1]) + (a[2] + a[3])) + ((b[0] + b[1]) + (b[2] + b[3])) + ((c[0] + c[1]) + (c[2] + c[3])) + ((d[0] + d[1]) + (d[2] + d[3]));
    return rsqrtf(s * (1.0f / D_) + EPS_);
}

struct EpiSwiglu {
    bf16_t* H; const float* rsv;
    struct Pre { float r[8]; };
    __device__ __forceinline__ Pre prefetch(const pg8::Unit& u, int wr, int fr) const {
        Pre p; const int row0 = u.pm * 256 + wr * 64 + fr;
#pragma unroll
        for (int i = 0; i < 8; ++i) p.r[i] = rsv[row0 + (i >> 2) * 128 + (i & 3) * 16];
        return p;
    }
    __device__ __forceinline__ void operator()(const f32x4 (&acc)[2][2][4][2], const pg8::Unit& u, int wr, int wc, int fr, int fq, const Pre& pre) const {
        const int row0 = u.pm * 256 + wr * 64 + fr, col0 = u.pn * 128 + wc * 32 + 8 * fq;
#pragma unroll
        for (int ai = 0; ai < 2; ++ai)
#pragma unroll
            for (int m = 0; m < 4; ++m) {
                const int row = row0 + ai * 128 + m * 16;
                const float rs = pre.r[ai * 4 + m], rs2 = rs * rs, nrl = rs * -1.4426950408889634f;
                float hv[8];
#pragma unroll
                for (int n = 0; n < 2; ++n)
#pragma unroll
                    for (int j = 0; j < 4; ++j) { const float ag = acc[ai][0][m][n][j], au = acc[ai][1][m][n][j]; hv[n * 4 + j] = (ag * au) * rs2 * __builtin_amdgcn_rcpf(1.0f + __builtin_amdgcn_exp2f(ag * nrl)); }
                u32x4 w; w.x = pk2(hv[0], hv[1]); w.y = pk2(hv[2], hv[3]); w.z = pk2(hv[4], hv[5]); w.w = pk2(hv[6], hv[7]);
                *(u32x4*)(H + (size_t)row * FF_ + col0) = w;
            }
    }
};
struct EpiResid {
    const float* Xin; float* Xout; bf16_t* XB; float* ss; float scale; int write_xb;
    struct Pre {};
    __device__ __forceinline__ Pre prefetch(const pg8::Unit&, int, int) const { return Pre{}; }
    __device__ __forceinline__ void operator()(const f32x4 (&acc)[2][2][4][2], const pg8::Unit& u, int wr, int wc, int fr, int fq, const Pre&) const {
        const int row0 = u.pm * 256 + wr * 64 + fr, col0 = u.pn * 256 + wc * 32 + 8 * fq;
        f32x4 xw[3][2][2];
#define ER_LOAD(s_) do { const size_t o_ = (size_t)(row0 + ((s_) >> 2) * 128 + ((s_) & 3) * 16) * D_ + col0; _Pragma("unroll") for (int bj = 0; bj < 2; ++bj) { \
            xw[(s_) % 3][bj][0] = *(const f32x4*)(Xin + o_ + bj * 128); xw[(s_) % 3][bj][1] = *(const f32x4*)(Xin + o_ + bj * 128 + 4); } } while (0)
        ER_LOAD(0); ER_LOAD(1);
#pragma unroll
        for (int s = 0; s < 8; ++s) {
            if (s + 2 < 8) ER_LOAD(s + 2);
            const int ai = s >> 2, m = s & 3;
            const int row = row0 + ai * 128 + m * 16;
            float sq = 0.f;
#pragma unroll
            for (int bj = 0; bj < 2; ++bj) {
                const size_t o = (size_t)row * D_ + col0 + bj * 128;
                const f32x4 x0 = xw[s % 3][bj][0] + acc[ai][bj][m][0] * scale, x1 = xw[s % 3][bj][1] + acc[ai][bj][m][1] * scale;
                __builtin_nontemporal_store(x0, (f32x4*)(Xout + o)); __builtin_nontemporal_store(x1, (f32x4*)(Xout + o + 4));
                u32x4 w; w.x = pk2(x0[0], x0[1]); w.y = pk2(x0[2], x0[3]); w.z = pk2(x1[0], x1[1]); w.w = pk2(x1[2], x1[3]);
                if (write_xb) *(u32x4*)(XB + o) = w;
                sq += (x0[0] * x0[0] + x0[1] * x0[1]) + (x0[2] * x0[2] + x0[3] * x0[3]) + (x1[0] * x1[0] + x1[1] * x1[1]) + (x1[2] * x1[2] + x1[3] * x1[3]);
            }
            sq += __shfl_xor(sq, 16); sq += __shfl_xor(sq, 32);
            if (fq == 0) ss[(size_t)row * 16 + u.pn * 4 + wc] = sq;
        }
#undef ER_LOAD
    }
};
struct EpiProj {
    bf16_t* Pj; int ldp; const float* rsv; float* gates; int gate_col0;
    struct Pre { float r[8]; };
    __device__ __forceinline__ Pre prefetch(const pg8::Unit& u, int wr, int fr) const {
        Pre p; const int row0 = u.pm * 256 + wr * 64 + fr;
#pragma unroll
        for (int i = 0; i < 8; ++i) p.r[i] = rsv[row0 + (i >> 2) * 128 + (i & 3) * 16];
        return p;
    }
    __device__ __forceinline__ void operator()(const f32x4 (&acc)[2][2][4][2], const pg8::Unit& u, int wr, int wc, int fr, int fq, const Pre& pre) const {
        const int row0 = u.pm * 256 + wr * 64 + fr, col0 = u.pn * 256 + wc * 32 + 8 * fq;
#pragma unroll
        for (int ai = 0; ai < 2; ++ai)
#pragma unroll
            for (int m = 0; m < 4; ++m) {
                const int row = row0 + ai * 128 + m * 16;
                const float rs = pre.r[ai * 4 + m];
#pragma unroll
                for (int bj = 0; bj < 2; ++bj) {
                    const f32x4 v0 = acc[ai][bj][m][0] * rs, v1 = acc[ai][bj][m][1] * rs;
                    u32x4 w; w.x = pk2(v0[0], v0[1]); w.y = pk2(v0[2], v0[3]); w.z = pk2(v1[0], v1[1]); w.w = pk2(v1[2], v1[3]);
                    if (col0 + bj * 128 < 3584) *(u32x4*)(Pj + (size_t)row * ldp + col0 + bj * 128) = w;
                    if (gates != nullptr && bj == 0 && col0 == gate_col0) { *(f32x4*)(gates + (size_t)row * 8) = v0; *(f32x4*)(gates + (size_t)row * 8 + 4) = v1; }
                }
            }
    }
};

struct ConvJob { const float* W; const float* gain; bf16_t* out; int ldw, K, k0, n0, mode; };
constexpr int T_W1 = 16 * 44, T_W2 = 44 * 8, T_ABI = 16 * 28, T_SQ = 16 * 8, T_CDI = 16 * 30;
__host__ __device__ constexpr int conv_ntiles(int m) { return m < 0 ? 0 : (m < 4 ? T_W1 : (m < 8 ? T_W2 : (m == 8 ? T_ABI : (m == 10 ? T_CDI : T_SQ)))); }
__device__ __forceinline__ ConvJob conv_decode_m(const Params& P, int m, int t) {
    ConvJob j; unsigned char* ws = P.ws; int ntn;
    if (m < 4) { j.W = P.ffn_w_in + (size_t)m * D_ * NFF1; j.gain = P.ffn_norm + (size_t)m * D_; j.out = (bf16_t*)(ws + OFF_W1T + m * SZ_W1T); j.ldw = NFF1; j.K = D_; j.mode = 1; ntn = 44; }
    else if (m < 8) { const int i = m - 4; j.W = P.ffn_w_out + (size_t)i * FF_ * D_; j.gain = nullptr; j.out = (bf16_t*)(ws + OFF_W2T + i * SZ_W2T); j.ldw = D_; j.K = FF_; j.mode = 0; ntn = 8; }
    else if (m == 8) { j.W = P.ab_w_in; j.gain = P.mix_norm; j.out = (bf16_t*)(ws + OFF_ABIN); j.ldw = NAB; j.K = D_; j.mode = 0; ntn = 28; }
    else if (m == 9) { j.W = P.ab_w_out; j.gain = nullptr; j.out = (bf16_t*)(ws + OFF_ABOUT); j.ldw = D_; j.K = D_; j.mode = 0; ntn = 8; }
    else if (m == 10) { j.W = P.cd_w_in; j.gain = P.mix_norm + D_; j.out = (bf16_t*)(ws + OFF_CDIN); j.ldw = 3592; j.K = D_; j.mode = 2; ntn = 30; }
    else { j.W = P.cd_w_out; j.gain = nullptr; j.out = (bf16_t*)(ws + OFF_CDOUT); j.ldw = D_; j.K = D_; j.mode = 0; ntn = 8; }
    j.k0 = (t / ntn) * 64; j.n0 = (t % ntn) * 128;
    return j;
}
__device__ __forceinline__ void conv_load(const ConvJob& j, int tid, f32x4 (&r)[4]) {
#pragma unroll
    for (int i = 0; i < 4; ++i) {
        const int c = tid + 512 * i, kk = c >> 5, n4 = (c & 31) * 4, nn = n4 & 63, n0h = j.n0 + (n4 & 64);
        int src0 = n0h, cnt = 64;
        if (j.mode == 1) { const int pn = n0h >> 8, within = n0h & 255, bj = within >> 7, off = within & 127; src0 = bj * FF_ + pn * 128 + off; }
        else if (j.mode == 2) { if (n0h < 2048) src0 = n0h; else if (n0h < 3584) src0 = n0h + 8; else if (n0h == 3584) { src0 = 2048; cnt = 8; } else { src0 = 0; cnt = 0; } }
        f32x4 v = (f32x4){0.f, 0.f, 0.f, 0.f};
        if (nn < cnt) { v = *(const f32x4*)(j.W + (size_t)(j.k0 + kk) * j.ldw + src0 + nn); if (j.gain) v = v * j.gain[j.k0 + kk]; }
        r[i] = v;
    }
}
template <int M0, int M1, int M2, int M3>
__device__ __forceinline__ void conv_batch(const Params& P, float* tile, int worker, int nworkers) {
    constexpr int n0 = conv_ntiles(M0), n1 = n0 + conv_ntiles(M1), n2 = n1 + conv_ntiles(M2), n3 = n2 + conv_ntiles(M3);
    const int tid = ltid();
    int t = worker;
    if (t >= n3) return;
#define CONV_DEC(t_) ((t_) < n0 ? conv_decode_m(P, M0, (t_)) : ((t_) < n1 ? conv_decode_m(P, M1, (t_) - n0) : ((t_) < n2 ? conv_decode_m(P, M2, (t_) - n1) : conv_decode_m(P, M3, (t_) - n2))))
    ConvJob j = CONV_DEC(t);
    f32x4 r[4];
    conv_load(j, tid, r);
    for (;;) {
#pragma unroll
        for (int i = 0; i < 4; ++i) { const int c = tid + 512 * i, kk = c >> 5, n4 = (c & 31) * 4; float* tp = tile + kk * 129 + n4; tp[0] = r[i][0]; tp[1] = r[i][1]; tp[2] = r[i][2]; tp[3] = r[i][3]; }
        const ConvJob cur = j;
        const int tn = t + nworkers; const bool more = tn < n3;
        if (more) { j = CONV_DEC(tn); conv_load(j, tid, r); }
        __syncthreads();
        {
            const int nn = tid >> 2, kq = (tid & 3) * 16;
            const float* tp = tile + kq * 129 + nn;
            u32x4 w0, w1;
            w0.x = pk2(tp[0 * 129], tp[1 * 129]); w0.y = pk2(tp[2 * 129], tp[3 * 129]); w0.z = pk2(tp[4 * 129], tp[5 * 129]); w0.w = pk2(tp[6 * 129], tp[7 * 129]);
            w1.x = pk2(tp[8 * 129], tp[9 * 129]); w1.y = pk2(tp[10 * 129], tp[11 * 129]); w1.z = pk2(tp[12 * 129], tp[13 * 129]); w1.w = pk2(tp[14 * 129], tp[15 * 129]);
            bf16_t* op = cur.out + (size_t)(cur.n0 + nn) * cur.K + cur.k0 + kq;
            *(u32x4*)op = w0; *(u32x4*)(op + 8) = w1;
        }
        __syncthreads();
        if (!more) break;
        t = tn;
    }
#undef CONV_DEC
}
template <class Epi> __device__ __forceinline__ void run_gemm(LAS unsigned char* lds, const bf16_t* A, const bf16_t* Bt, int N, int K, const Epi& E, const float* ss, float* rsv, const Params& P, unsigned char* lds_generic, int cbatch) {
    pg8::Gemm g{A, Bt, M_, N, K}; pg8::StaticOrder S; S.init(M_, N, (int)gridDim.x, (int)blockIdx.x);
    if (rsv != nullptr) {
        const int tid = ltid(), r = tid >> 1, hsel = tid & 1;
        f32x4 pa[8], pb[8]; unsigned okm = 0u; int rows[8];
#pragma unroll
        for (int i = 0; i < 8; ++i) {
            pg8::Unit u; const bool ok = S.next(i, u);
            rows[i] = ok ? u.pm * 256 + r : r;
            const f32x4* sp = (const f32x4*)(ss + (size_t)rows[i] * 16 + hsel * 8);
            pa[i] = sp[0]; pb[i] = sp[1];
            okm |= ok ? (1u << i) : 0u;
        }
#pragma unroll
        for (int i = 0; i < 8; ++i) {
            float s = ((pa[i][0] + pa[i][1]) + (pa[i][2] + pa[i][3])) + ((pb[i][0] + pb[i][1]) + (pb[i][2] + pb[i][3]));
            s += __shfl_xor(s, 1);
            if (hsel == 0 && ((okm >> i) & 1u)) rsv[rows[i]] = rsqrtf(s * (1.0f / D_) + EPS_);
        }
        __syncthreads();
    }
    pg8::gemm_phase<Epi>(lds, g, S, E);
    if (cbatch != 0) {
        const int r = S.nwg % S.G;
        if (r != 0 && (int)blockIdx.x >= r) {
            float* tile = (float*)(const_cast<unsigned char*>((const unsigned char*)lds_generic));
            const int worker = (int)blockIdx.x - r, nworkers = S.G - r;
            if (cbatch == 1) conv_batch<1, 5, -1, -1>(P, tile, worker, nworkers);
            else if (cbatch == 2) conv_batch<9, 2, 11, -1>(P, tile, worker, nworkers);
            else if (cbatch == 3) conv_batch<6, 10, 7, -1>(P, tile, worker, nworkers);
            else conv_batch<3, -1, -1, -1>(P, tile, worker, nworkers);
        }
    }
}

__device__ __forceinline__ void phase_prologue(const Params& P, float* L) {
    const int tid = ltid(), bid = blockIdx.x, nb = gridDim.x, wave = tid >> 6, lane = tid & 63;
    unsigned char* ws = P.ws;
    {
        bf16_t* __restrict__ XB = (bf16_t*)(ws + OFF_XB); float* __restrict__ SS = (float*)(ws + OFF_SS); const float* __restrict__ xin_ = P.x;
        for (int row = bid * 8 + wave; row < M_; row += nb * 8) {
            const f32x4* xr = (const f32x4*)(xin_ + (size_t)row * D_);
            float sq = 0.f;
#pragma unroll
            for (int i = 0; i < 4; ++i) {
                const f32x4 v = xr[lane + 64 * i];
                sq += (v[0] * v[0] + v[1] * v[1]) + (v[2] * v[2] + v[3] * v[3]);
                u32x2 pk; pk.x = pk2(v[0], v[1]); pk.y = pk2(v[2], v[3]);
                *(u32x2*)(XB + (size_t)row * D_ + (lane + 64 * i) * 4) = pk;
            }
            sq = wave_sum(sq);
            if (lane < 16) SS[(size_t)row * 16 + lane] = (lane == 0) ? sq : 0.f;
        }
    }
    conv_batch<0, 4, 8, -1>(P, L, (int)blockIdx.x, (int)gridDim.x);
    if (bid == 0) {
        float* LB = (float*)(ws + OFF_LB);
        const float l0 = P.lb_logits[tid], l1 = P.lb_logits[512 + tid], l2 = P.lb_logits[1024 + tid];
        const float mx = fmaxf(l0, fmaxf(l1, l2)), e0 = __expf(l0 - mx), e1 = __expf(l1 - mx), e2 = __expf(l2 - mx);
        LB[tid] = e0 / (e0 + e1 + e2);
    }
}

__device__ __forceinline__ void phase_conv(const Params& P) {
    const bf16_t* __restrict__ PJ = (const bf16_t*)(P.ws + OFF_HP); bf16_t* __restrict__ Y = (bf16_t*)(P.ws + OFF_Y);
    const int ch = ltid();
    const float w0 = P.conv_w[ch], w1 = P.conv_w[512 + ch], w2 = P.conv_w[1024 + ch], cb = P.conv_b[ch];
    for (int blk = blockIdx.x; blk < M_ / 64; blk += gridDim.x) {
        const int r0 = blk * 64;
        float z2 = 0.f, z1 = 0.f;
        if ((r0 & (SEQ_ - 1)) != 0) {
            const bf16_t* a = PJ + (size_t)(r0 - 2) * NAB; const bf16_t* c = PJ + (size_t)(r0 - 1) * NAB;
            z2 = bf2f(a[2560 + ch]) * bf2f(a[3072 + ch]); z1 = bf2f(c[2560 + ch]) * bf2f(c[3072 + ch]);
        }
#pragma unroll 1
        for (int t0 = 0; t0 < 64; t0 += 16) {
            bf16_t rb[16], rc[16], ru[16];
#pragma unroll
            for (int t = 0; t < 16; ++t) { const bf16_t* r = PJ + (size_t)(r0 + t0 + t) * NAB; rb[t] = r[2048 + ch]; rc[t] = r[2560 + ch]; ru[t] = r[3072 + ch]; }
#pragma unroll
            for (int t = 0; t < 16; ++t) {
                const float z0 = bf2f(rc[t]) * bf2f(ru[t]);
                const float y = bf2f(rb[t]) * (cb + w0 * z2 + w1 * z1 + w2 * z0);
                Y[(size_t)(r0 + t0 + t) * D_ + 512 + ch] = f2bf(y);
                z2 = z1; z1 = z0;
            }
        }
    }
}
__device__ __forceinline__ void phase_scan(float* ST, const float* DEC, int per_channel) {
    for (int gid = blockIdx.x * 512 + ltid(); gid < 8 * 16384; gid += gridDim.x * 512) {
        const int bh = gid >> 14, dv = gid & 16383, d = dv & 127;
        float tv[32], dc[32];
#pragma unroll
        for (int p = 0; p < 32; ++p) { const int w = bh * 32 + p; tv[p] = ST[(size_t)w * 16384 + dv]; dc[p] = per_channel ? DEC[w * 128 + d] : DEC[w]; }
        float S = 0.f;
#pragma unroll
        for (int p = 0; p < 32; ++p) { const int w = bh * 32 + p; ST[(size_t)w * 16384 + dv] = S; S = dc[p] * S + tv[p]; }
    }
}
__device__ __forceinline__ void phase_scan_n(float* NS, const float* DSEG) {
    for (int gid = blockIdx.x * 512 + ltid(); gid < 8 * 128; gid += gridDim.x * 512) {
        const int bh = gid >> 7, d = gid & 127;
        float tv[32], dc[32];
#pragma unroll
        for (int p = 0; p < 32; ++p) { const int w = bh * 32 + p; tv[p] = NS[w * 128 + d]; dc[p] = DSEG[w]; }
        float S = 0.f;
#pragma unroll
        for (int p = 0; p < 32; ++p) { const int w = bh * 32 + p; NS[w * 128 + d] = S; S = dc[p] * S + tv[p]; }
    }
}
__device__ __forceinline__ void phase_moba_pre(const Params& P, float* L) {
    bf16_t* PJ = (bf16_t*)(P.ws + OFF_HP); float* KM = (float*)(P.ws + OFF_KMEAN);
    const int tid = ltid();
    const float qscale = 0.08838834764831845f;
    for (int w = blockIdx.x; w < 256; w += gridDim.x) {
        const int b = w >> 7, n = (w >> 2) & 31, h = w & 3;
        const int row0 = b * SEQ_ + n * 256;
        __syncthreads();
        {
            float q1[8], q2[8], k1[8], k2[8];
#pragma unroll
            for (int u = 0; u < 8; ++u) {
                const int e = tid + 512 * u, t = e >> 4, i = e & 15;
                const bf16_t* qp = PJ + (size_t)(row0 + t) * NCD + 2048 + h * 128 + i;
                const bf16_t* kp = PJ + (size_t)(row0 + t) * NCD + 2560 + h * 128 + i;
                q1[u] = bf2f(qp[0]); q2[u] = bf2f(qp[16]); k1[u] = bf2f(kp[0]); k2[u] = bf2f(kp[16]);
            }
#pragma unroll
            for (int u = 0; u < 8; ++u) {
                const int e = tid + 512 * u, t = e >> 4, i = e & 15;
                const int pos = n * 256 + t;
                const float invf = exp2f(-(float)i * (18.931568569324174f / 16.0f));
                const float ang = (float)pos * invf;
                double rev = (double)ang * 0.15915494309189535; rev -= rint(rev);
                const float sn = __builtin_amdgcn_sinf((float)rev), cs = __builtin_amdgcn_cosf((float)rev);
                bf16_t* qp = PJ + (size_t)(row0 + t) * NCD + 2048 + h * 128 + i;
                bf16_t* kp = PJ + (size_t)(row0 + t) * NCD + 2560 + h * 128 + i;
                qp[0] = f2bf(q1[u] * cs - q2[u] * sn); qp[16] = f2bf(q2[u] * cs + q1[u] * sn);
                kp[0] = f2bf(k1[u] * cs - k2[u] * sn); kp[16] = f2bf(k2[u] * cs + k1[u] * sn);
            }
        }
        __syncthreads();
        {
            const int col = tid & 127, tq = tid >> 7;
            float s = 0.f;
            for (int t = 0; t < 64; ++t) s += bf2f(PJ[(size_t)(row0 + tq * 64 + t) * NCD + 2560 + h * 128 + col]);
            L[tq * 128 + col] = s;
        }
        __syncthreads();
        if (tid < 128) KM[(size_t)((b * 4 + h) * 32 + n) * 128 + tid] = ((L[tid] + L[128 + tid]) + (L[256 + tid] + L[384 + tid])) * (1.0f / 256.0f);
        {
            bf16_t* VT = (bf16_t*)(P.ws + OFF_W1T);
            unsigned char* T = (unsigned char*)L + 4096;
#pragma unroll 2
            for (int i = 0; i < 8; ++i) { const int c = tid + 512 * i, r = c >> 4, c16 = c & 15;
                *(u32x4*)(T + r * 272 + c16 * 16) = *(const u32x4*)(PJ + (size_t)(row0 + r) * NCD + 3072 + h * 128 + c16 * 8); }
            __syncthreads();
#pragma unroll 2
            for (int i = 0; i < 8; ++i) { const int c = tid + 512 * i, vcol = c & 127, t8 = c >> 7;
                const unsigned char* tp = T + (t8 * 8) * 272 + vcol * 2;
                u32x4 wv;
                wv.x = (unsigned)*(const bf16_t*)(tp) | ((unsigned)*(const bf16_t*)(tp + 272) << 16);
                wv.y = (unsigned)*(const bf16_t*)(tp + 2 * 272) | ((unsigned)*(const bf16_t*)(tp + 3 * 272) << 16);
                wv.z = (unsigned)*(const bf16_t*)(tp + 4 * 272) | ((unsigned)*(const bf16_t*)(tp + 5 * 272) << 16);
                wv.w = (unsigned)*(const bf16_t*)(tp + 6 * 272) | ((unsigned)*(const bf16_t*)(tp + 7 * 272) << 16);
                *(u32x4*)(VT + (size_t)((b * 4 + h) * 128 + vcol) * SEQ_ + n * 256 + t8 * 8) = wv; }
        }
    }
}
constexpr int MB_S = 272;
constexpr int MB_BUF = 2 * 128 * MB_S;
constexpr int MB_OFF_K = 0, MB_OFF_VT = 128 * MB_S, MB_OFF_KM = MB_BUF, MB_OFF_P = MB_BUF + 16384, MB_OFF_SM = 2 * MB_BUF;
constexpr int LDS_MISC_OFF = 2 * MB_BUF + 512;
constexpr int LDS_TOTAL = LDS_MISC_OFF + 64;
__device__ __forceinline__ void phase_moba_attn_mfma(const Params& P, unsigned char* smem) {
    const bf16_t* PJ = (const bf16_t*)(P.ws + OFF_HP); bf16_t* Y = (bf16_t*)(P.ws + OFF_Y); const float* KM = (const float*)(P.ws + OFF_KMEAN);
    const bf16_t* VT = (const bf16_t*)(P.ws + OFF_W1T);
    const int tid = ltid(), wave = tid >> 6, lane = tid & 63, li = lane & 15, quad = lane >> 4;
    unsigned char* Kl = smem + MB_OFF_K; unsigned char* VTl = smem + MB_OFF_VT; unsigned char* Pw = smem + MB_OFF_P + wave * 16 * MB_S;
    float* KMl = (float*)(smem + MB_OFF_KM); float* SC = (float*)(smem + MB_OFF_P); unsigned* SM = (unsigned*)(smem + MB_OFF_SM);
    const float NEG_INF = -__builtin_inff();
    const float MB_C = 0.08838834764831845f * 1.4426950408889634f;
    for (int w = blockIdx.x; w < 256; w += gridDim.x) {
#pragma unroll 1
        for (int half = 0; half < 2; ++half) {
            const int bh = w & 7, ii = w >> 3, qt = half ? ii : 63 - ii;
            const int b = bh >> 2, h = bh & 3, own = qt >> 1, q0 = qt * 128;
            const size_t rowbase = (size_t)b * SEQ_;
            __syncthreads();
#pragma unroll
            for (int i = 0; i < 4; ++i) { const int c = tid + 512 * i, r = c >> 4, c16 = c & 15;
                *(u32x4*)(Kl + r * MB_S + c16 * 16) = *(const u32x4*)(PJ + (rowbase + q0 + r) * NCD + 2048 + h * 128 + c16 * 8); }
#pragma unroll
            for (int i = 0; i < 2; ++i) { const int c = tid + 512 * i; ((u32x4*)KMl)[c] = ((const u32x4*)(KM + (size_t)(bh * 32) * 128))[c]; }
            __syncthreads();
            {
                const int q = tid & 127, g = tid >> 7;
                float s8[8];
#pragma unroll
                for (int nn = 0; nn < 8; ++nn) s8[nn] = 0.f;
#pragma unroll 2
                for (int d8 = 0; d8 < 16; ++d8) {
                    const u32x4 qw = *(const u32x4*)(Kl + q * MB_S + d8 * 16);
                    const float q0f = __uint_as_float(qw.x << 16), q1f = __uint_as_float(qw.x & 0xFFFF0000u), q2f = __uint_as_float(qw.y << 16), q3f = __uint_as_float(qw.y & 0xFFFF0000u);
                    const float q4f = __uint_as_float(qw.z << 16), q5f = __uint_as_float(qw.z & 0xFFFF0000u), q6f = __uint_as_float(qw.w << 16), q7f = __uint_as_float(qw.w & 0xFFFF0000u);
#pragma unroll
                    for (int nn = 0; nn < 8; ++nn) {
                        const float* km = KMl + (g * 8 + nn) * 128 + d8 * 8;
                        const f32x4 k0 = *(const f32x4*)km, k1 = *(const f32x4*)(km + 4);
                        s8[nn] += (q0f * k0[0] + q1f * k0[1]) + (q2f * k0[2] + q3f * k0[3]) + (q4f * k1[0] + q5f * k1[1]) + (q6f * k1[2] + q7f * k1[3]);
                    }
                }
#pragma unroll
                for (int nn = 0; nn < 8; ++nn) { const int n = g * 8 + nn; SC[q * 33 + n] = (n < own) ? s8[nn] : NEG_INF; }
            }
            __syncthreads();
            if (tid < 128) {
                unsigned mask = 1u << own;
                float sc[32];
#pragma unroll
                for (int n = 0; n < 32; ++n) sc[n] = SC[tid * 33 + n];
#pragma unroll
                for (int r = 0; r < 3; ++r) {
                    float best = NEG_INF; int bi = -1;
#pragma unroll
                    for (int n = 0; n < 32; ++n) { const bool gt = sc[n] > best; best = gt ? sc[n] : best; bi = gt ? n : bi; }
                    if (bi >= 0) mask |= 1u << bi;
#pragma unroll
                    for (int n = 0; n < 32; ++n) sc[n] = (n == bi) ? NEG_INF : sc[n];
                }
                SM[tid] = mask;
            }
            __syncthreads();
            bf16x8 qf[4];
#pragma unroll
            for (int kc = 0; kc < 4; ++kc) qf[kc] = *(const bf16x8*)(Kl + (wave * 16 + li) * MB_S + (kc * 32 + quad * 8) * 2);
            const unsigned smq = SM[wave * 16 + li];
            unsigned wum = smq;
            wum |= __shfl_xor(wum, 1); wum |= __shfl_xor(wum, 2); wum |= __shfl_xor(wum, 4); wum |= __shfl_xor(wum, 8);
            unsigned um = SM[lane] | SM[64 + lane];
#pragma unroll
            for (int o = 32; o >= 1; o >>= 1) um |= __shfl_xor(um, o);
            um = __builtin_amdgcn_readfirstlane(um); wum = __builtin_amdgcn_readfirstlane(wum);
            const int qpos = q0 + wave * 16 + li;
            float m = NEG_INF, l = 0.f; f32x4 O[8];
#pragma unroll
            for (int vt = 0; vt < 8; ++vt) O[vt] = (f32x4){0.f, 0.f, 0.f, 0.f};
            const int nsteps = 2 * (own + 1);
#define MB_VALID(s_) ((((um >> (own - ((s_) >> 1))) & 1u) != 0u) && !((((s_) >> 1) == 0) && ((own * 256 + ((s_) & 1) * 128) > q0 + 127)))
            int step = 0;
            while (step < nsteps && !MB_VALID(step)) ++step;
            int nstep = step + 1;
            while (nstep < nsteps && !MB_VALID(nstep)) ++nstep;
            u32x4 kreg[4], vreg[4];
            const int sr = tid >> 4, sc16 = tid & 15;
#define MB_GLOAD(s_) do { const int k0_ = (own - ((s_) >> 1)) * 256 + ((s_) & 1) * 128; _Pragma("unroll") for (int i = 0; i < 4; ++i) { \
                kreg[i] = *(const u32x4*)(PJ + (rowbase + k0_ + sr + 32 * i) * NCD + 2560 + h * 128 + sc16 * 8); \
                vreg[i] = *(const u32x4*)(VT + (size_t)(bh * 128 + sr + 32 * i) * SEQ_ + k0_ + sc16 * 8); } } while (0)
            const int vperm_lo = (sc16 >> 2) * 64 + (((sc16 & 3) < 2) ? 4 * (sc16 & 3) : 4 * ((sc16 & 3) - 2) + 1) * 8;
#define MB_LWRITE(buf_) do { _Pragma("unroll") for (int i = 0; i < 4; ++i) { *(u32x4*)(smem + (buf_) * MB_BUF + MB_OFF_K + (sr + 32 * i) * MB_S + sc16 * 16) = kreg[i]; \
                unsigned char* vrow_ = smem + (buf_) * MB_BUF + MB_OFF_VT + (sr + 32 * i) * MB_S + vperm_lo; u32x2 lo_, hi_; lo_.x = vreg[i].x; lo_.y = vreg[i].y; hi_.x = vreg[i].z; hi_.y = vreg[i].w; \
                *(u32x2*)vrow_ = lo_; *(u32x2*)(vrow_ + 16) = hi_; } } while (0)
            if (step < nsteps) MB_GLOAD(step);
            lds_barrier();
            if (step < nsteps) { MB_LWRITE(0); if (nstep < nsteps) MB_GLOAD(nstep); }
            int bufi = 0;
#pragma unroll 1
            while (step < nsteps) {
                const int n = own - (step >> 1), key0 = n * 256 + (step & 1) * 128;
                unsigned char* Kl = smem + bufi * MB_BUF + MB_OFF_K; unsigned char* VTl = smem + bufi * MB_BUF + MB_OFF_VT;
                lds_barrier();
                int nnstep = nstep + 1;
                while (nnstep < nsteps && !MB_VALID(nnstep)) ++nnstep;
                if (nstep < nsteps) { MB_LWRITE(bufi ^ 1); if (nnstep < nsteps) MB_GLOAD(nnstep); }
                if ((wum >> n) & 1u) {
                    f32x4 S[8];
                    {
                        bf16x8 kf[2][4];
#define MB_LDK(slot, st_) do { _Pragma("unroll") for (int kc = 0; kc < 4; ++kc) kf[slot][kc] = *(const bf16x8*)(Kl + ((st_) * 16 + li) * MB_S + (kc * 32 + quad * 8) * 2); } while (0)
                        MB_LDK(0, 0);
#pragma unroll
                        for (int st = 0; st < 8; ++st) {
                            if (st + 1 < 8) MB_LDK((st + 1) & 1, st + 1);
                            __builtin_amdgcn_sched_barrier(0);
                            f32x4 acc = (f32x4){0.f, 0.f, 0.f, 0.f};
#pragma unroll
                            for (int kc = 0; kc < 4; ++kc) acc = __builtin_amdgcn_mfma_f32_16x16x32_bf16(kf[st & 1][kc], qf[kc], acc, 0, 0, 0);
                            S[st] = acc;
                            __builtin_amdgcn_sched_barrier(0);
                        }
#undef MB_LDK
                    }
                    const bool sel = (smq >> n) & 1u;
                    float mj = NEG_INF;
                    if (n == own) {
#pragma unroll
                        for (int st = 0; st < 8; ++st)
#pragma unroll
                            for (int j = 0; j < 4; ++j) { const int kpos = key0 + st * 16 + quad * 4 + j; const float sv = (kpos <= qpos) ? S[st][j] : NEG_INF; S[st][j] = sv; mj = fmaxf(mj, sv); }
                    } else {
#pragma unroll
                        for (int st = 0; st < 8; ++st) mj = fmaxf(fmaxf(mj, fmaxf(S[st][0], S[st][1])), fmaxf(S[st][2], S[st][3]));
                        mj = sel ? mj : NEG_INF;
                    }
                    mj = fmaxf(mj, __shfl_xor(mj, 16)); mj = fmaxf(mj, __shfl_xor(mj, 32));
                    const float mn = fmaxf(m, mj), msafe = (mn == NEG_INF) ? 0.f : mn;
                    const float alpha = __builtin_amdgcn_exp2f((m - msafe) * MB_C);
                    const float mc = sel ? msafe * MB_C : __builtin_inff();
                    float ls = 0.f;
#pragma unroll
                    for (int st = 0; st < 8; ++st)
#pragma unroll
                        for (int j = 0; j < 4; ++j) { const float pe = __builtin_amdgcn_exp2f(fmaf(S[st][j], MB_C, -mc)); S[st][j] = pe; ls += pe; }
                    ls += __shfl_xor(ls, 16); ls += __shfl_xor(ls, 32);
                    l = l * alpha + ls; m = mn;
                    if (__builtin_amdgcn_ballot_w64(alpha != 1.0f) != 0ull) {
#pragma unroll
                        for (int vt = 0; vt < 8; ++vt) O[vt] *= alpha;
                    }
                    {
                        bf16x8 pf[4];
#pragma unroll
                        for (int c = 0; c < 4; ++c) { u32x4 pw; pw.x = cvt_pk_bf16(S[2 * c][0], S[2 * c][1]); pw.y = cvt_pk_bf16(S[2 * c][2], S[2 * c][3]); pw.z = cvt_pk_bf16(S[2 * c + 1][0], S[2 * c + 1][1]); pw.w = cvt_pk_bf16(S[2 * c + 1][2], S[2 * c + 1][3]); pf[c] = __builtin_bit_cast(bf16x8, pw); }
                        u32x4 vfr[4];
#define MB_LDV(slot, g_) do { vfr[slot] = *(const u32x4*)(VTl + ((((g_) & 7) * 16) + li) * MB_S + ((g_) >> 3) * 64 + quad * 16); } while (0)
                        MB_LDV(0, 0); MB_LDV(1, 1); MB_LDV(2, 2);
#pragma unroll
                        for (int g = 0; g < 32; ++g) {
                            if (g + 3 < 32) MB_LDV((g + 3) & 3, g + 3);
                            __builtin_amdgcn_sched_barrier(0);
                            O[g & 7] = __builtin_amdgcn_mfma_f32_16x16x32_bf16(__builtin_bit_cast(bf16x8, vfr[g & 3]), pf[g >> 3], O[g & 7], 0, 0, 0);
                            __builtin_amdgcn_sched_barrier(0);
                        }
#undef MB_LDV
                    }
                }
                step = nstep; nstep = nnstep; bufi ^= 1;
            }
#undef MB_GLOAD
#undef MB_LWRITE
#undef MB_VALID
            {
                const float inv = 1.0f / l;
                bf16_t* yp = Y + (rowbase + qpos) * D_ + 512 + h * 128 + quad * 4;
#pragma unroll
                for (int vt = 0; vt < 8; ++vt) { u32x2 w2; w2.x = cvt_pk_bf16(O[vt][0] * inv, O[vt][1] * inv); w2.y = cvt_pk_bf16(O[vt][2] * inv, O[vt][3] * inv); *(u32x2*)(yp + vt * 16) = w2; }
            }
        }
    }
}

constexpr int ML_OFF_K = 0, ML_OFF_VT = 128 * MB_S, ML_OFF_Q = 2 * 128 * MB_S, ML_OFF_TAB = 3 * 128 * MB_S;
__device__ __forceinline__ void phase_mlstm_A2(const Params& P, unsigned char* smem) {
    unsigned char* ws = P.ws;
    const bf16_t* PJ = (const bf16_t*)(ws + OFF_HP); const float* GATES = (const float*)(ws + OFF_GATES);
    float* NUML = (float*)(ws + OFF_OLOC); float* DENL = (float*)(ws + OFF_DENL); float* CUMF = (float*)(ws + OFF_CUMF);
    float* ST = (float*)(ws + OFF_ST); float* NS = (float*)(ws + OFF_NS); float* DSEG = (float*)(ws + OFF_DSEG);
    const int tid = ltid(), wave = tid >> 6, lane = tid & 63, li = lane & 15, quad = lane >> 4;
    unsigned char* Kl = smem + ML_OFF_K; unsigned char* VTl = smem + ML_OFF_VT; unsigned char* Ql = smem + ML_OFF_Q;
    float* Bq = (float*)(smem + ML_OFF_TAB); float* Gk = Bq + 256; float* We = Bq + 512; float* NR = Bq + 768;
    const float qscale = 0.08838834764831845f;
    const int sr = tid >> 4, sc16 = tid & 15;
    const int tr = tid & 31, tc16 = tid >> 5;
    for (int w = blockIdx.x; w < 256; w += gridDim.x) {
        const int b = w >> 7, h = (w >> 5) & 3, p = w & 31;
        const size_t row0 = (size_t)b * SEQ_ + p * 256;
        __syncthreads();
        if (tid < 64) {
            const float bi = P.gate_bias[h], bfg = P.gate_bias[4 + h];
            float lf[4], lg[4];
#pragma unroll
            for (int e = 0; e < 4; ++e) { const float* gp = GATES + (row0 + 4 * lane + e) * 8; lg[e] = gp[h] + bi; const float z = gp[4 + h] + bfg; lf[e] = (z >= 0.f) ? -log1pf(__expf(-z)) : (z - log1pf(__expf(z))); }
            const float c0 = lf[0], c1 = c0 + lf[1], c2 = c1 + lf[2], c3 = c2 + lf[3];
            float inc = c3;
#pragma unroll
            for (int o = 1; o < 64; o <<= 1) { const float up = __shfl_up(inc, o); if (lane >= o) inc += up; }
            const float pre = inc - c3, btot = __shfl(inc, 63);
            const float bb[4] = {pre + c0, pre + c1, pre + c2, pre + c3};
#pragma unroll
            for (int e = 0; e < 4; ++e) { const int t = 4 * lane + e; Bq[t] = bb[e]; Gk[t] = lg[e] - bb[e]; We[t] = __expf(btot - bb[e] + lg[e]); CUMF[(row0 + t) * 4 + h] = __expf(bb[e]); }
            if (lane == 63) DSEG[w] = __expf(btot);
        }
        f32x4 SC[8];
#pragma unroll
        for (int vt = 0; vt < 8; ++vt) SC[vt] = (f32x4){0.f, 0.f, 0.f, 0.f};
        float nacc = 0.f;
        bf16x8 qf[4]; f32x4 O[8]; float dtot = 0.f;
#pragma unroll
        for (int vt = 0; vt < 8; ++vt) O[vt] = (f32x4){0.f, 0.f, 0.f, 0.f};
#pragma unroll
        for (int kc = 0; kc < 4; ++kc) qf[kc] = (bf16x8){0, 0, 0, 0, 0, 0, 0, 0};
#pragma unroll 1
        for (int kt = 0; kt < 2; ++kt) {
            __syncthreads();
#pragma unroll
            for (int i = 0; i < 4; ++i) {
                *(u32x4*)(Kl + (sr + 32 * i) * MB_S + sc16 * 16) = *(const u32x4*)(PJ + (row0 + kt * 128 + sr + 32 * i) * NCD + 512 + h * 128 + sc16 * 8);
                const u32x4 vv = *(const u32x4*)(PJ + (row0 + kt * 128 + tr + 32 * i) * NCD + 1024 + h * 128 + tc16 * 8);
                unsigned char* vp = VTl + (tc16 * 8) * MB_S + (tr + 32 * i) * 2;
                *(bf16_t*)(vp) = (bf16_t)(vv.x & 0xFFFFu); *(bf16_t*)(vp + MB_S) = (bf16_t)(vv.x >> 16);
                *(bf16_t*)(vp + 2 * MB_S) = (bf16_t)(vv.y & 0xFFFFu); *(bf16_t*)(vp + 3 * MB_S) = (bf16_t)(vv.y >> 16);
                *(bf16_t*)(vp + 4 * MB_S) = (bf16_t)(vv.z & 0xFFFFu); *(bf16_t*)(vp + 5 * MB_S) = (bf16_t)(vv.z >> 16);
                *(bf16_t*)(vp + 6 * MB_S) = (bf16_t)(vv.w & 0xFFFFu); *(bf16_t*)(vp + 7 * MB_S) = (bf16_t)(vv.w >> 16);
            }
#pragma unroll 1
            for (int qt = kt; qt < 2; ++qt) {
                __syncthreads();
                if (kt == 0) {
#pragma unroll
                    for (int i = 0; i < 4; ++i) *(u32x4*)(Ql + (sr + 32 * i) * MB_S + sc16 * 16) = *(const u32x4*)(PJ + (row0 + qt * 128 + sr + 32 * i) * NCD + h * 128 + sc16 * 8);
                    __syncthreads();
#pragma unroll
                    for (int kc = 0; kc < 4; ++kc) qf[kc] = *(const bf16x8*)(Ql + (wave * 16 + li) * MB_S + (kc * 32 + quad * 8) * 2);
#pragma unroll
                    for (int vt = 0; vt < 8; ++vt) O[vt] = (f32x4){0.f, 0.f, 0.f, 0.f};
                    dtot = 0.f;
                }
                const int qtok = qt * 128 + wave * 16 + li;
                const float bq = Bq[qtok];
                const bool diag = (qt == kt);
                f32x4 S[8];
#pragma unroll
                for (int st = 0; st < 8; ++st) {
                    f32x4 acc = (f32x4){0.f, 0.f, 0.f, 0.f};
#pragma unroll
                    for (int kc = 0; kc < 4; ++kc) {
                        const bf16x8 kf = *(const bf16x8*)(Kl + (st * 16 + li) * MB_S + (kc * 32 + quad * 8) * 2);
                        acc = __builtin_amdgcn_mfma_f32_16x16x32_bf16(kf, qf[kc], acc, 0, 0, 0);
                    }
                    S[st] = acc;
                }
                __builtin_amdgcn_sched_barrier(0);
                float dsum = 0.f;
#pragma unroll
                for (int st = 0; st < 8; ++st) {
                    const f32x4 g4 = *(const f32x4*)(Gk + kt * 128 + st * 16 + quad * 4);
#pragma unroll
                    for (int j = 0; j < 4; ++j) {
                        const int ktok = kt * 128 + st * 16 + quad * 4 + j;
                        const float pe = (!diag || ktok <= qtok) ? S[st][j] * (qscale * __expf(bq + g4[j])) : 0.f;
                        S[st][j] = pe; dsum += pe;
                    }
                }
                dsum += __shfl_xor(dsum, 16); dsum += __shfl_xor(dsum, 32);
                dtot += dsum;
                __builtin_amdgcn_sched_barrier(0);
#pragma unroll
                for (int c = 0; c < 4; ++c) {
                    u32x4 pw; pw.x = cvt_pk_bf16(S[2 * c][0], S[2 * c][1]); pw.y = cvt_pk_bf16(S[2 * c][2], S[2 * c][3]); pw.z = cvt_pk_bf16(S[2 * c + 1][0], S[2 * c + 1][1]); pw.w = cvt_pk_bf16(S[2 * c + 1][2], S[2 * c + 1][3]);
                    const bf16x8 pf = __builtin_bit_cast(bf16x8, pw);
#pragma unroll
                    for (int vt = 0; vt < 8; ++vt) {
                        const unsigned char* vp = VTl + (vt * 16 + li) * MB_S + (c * 32 + quad * 4) * 2;
                        const u32x2 lo = *(const u32x2*)vp, hi = *(const u32x2*)(vp + 32);
                        u32x4 vw; vw.x = lo.x; vw.y = lo.y; vw.z = hi.x; vw.w = hi.y;
                        O[vt] = __builtin_amdgcn_mfma_f32_16x16x32_bf16(__builtin_bit_cast(bf16x8, vw), pf, O[vt], 0, 0, 0);
                    }
                }
                __builtin_amdgcn_sched_barrier(0);
                if (qt == kt) {
                    float* np_ = NUML + (row0 + qtok) * 512 + h * 128 + quad * 4;
#pragma unroll
                    for (int vt = 0; vt < 8; ++vt) *(f32x4*)(np_ + vt * 16) = O[vt];
                    if (quad == 0) DENL[(row0 + qtok) * 4 + h] = dtot;
                }
            }
            __builtin_amdgcn_sched_barrier(0);
#pragma unroll 1
            for (int kc = 0; kc < 4; ++kc) {
                const f32x4 w0 = *(const f32x4*)(We + kt * 128 + kc * 32 + quad * 8), w1 = *(const f32x4*)(We + kt * 128 + kc * 32 + quad * 8 + 4);
                const unsigned char* kp = Kl + (kc * 32 + quad * 8) * MB_S + (wave * 16 + li) * 2;
                u32x4 kw;
                kw.x = cvt_pk_bf16(bf2f(*(const bf16_t*)(kp)) * w0[0], bf2f(*(const bf16_t*)(kp + MB_S)) * w0[1]);
                kw.y = cvt_pk_bf16(bf2f(*(const bf16_t*)(kp + 2 * MB_S)) * w0[2], bf2f(*(const bf16_t*)(kp + 3 * MB_S)) * w0[3]);
                kw.z = cvt_pk_bf16(bf2f(*(const bf16_t*)(kp + 4 * MB_S)) * w1[0], bf2f(*(const bf16_t*)(kp + 5 * MB_S)) * w1[1]);
                kw.w = cvt_pk_bf16(bf2f(*(const bf16_t*)(kp + 6 * MB_S)) * w1[2], bf2f(*(const bf16_t*)(kp + 7 * MB_S)) * w1[3]);
                const bf16x8 kfr = __builtin_bit_cast(bf16x8, kw);
#pragma unroll
                for (int vt = 0; vt < 8; ++vt) {
                    const bf16x8 vf = *(const bf16x8*)(VTl + (vt * 16 + li) * MB_S + (kc * 32 + quad * 8) * 2);
                    SC[vt] = __builtin_amdgcn_mfma_f32_16x16x32_bf16(vf, kfr, SC[vt], 0, 0, 0);
                }
            }
            {
                const int d = tid & 127, g = tid >> 7;
#pragma unroll 4
                for (int t = 0; t < 32; ++t) nacc += We[kt * 128 + g * 32 + t] * bf2f(*(const bf16_t*)(Kl + (g * 32 + t) * MB_S + d * 2));
            }
        }
#pragma unroll
        for (int vt = 0; vt < 8; ++vt)
#pragma unroll
            for (int j = 0; j < 4; ++j) ST[(size_t)w * 16384 + (vt * 16 + quad * 4 + j) * 128 + wave * 16 + li] = SC[vt][j];
        NR[(tid >> 7) * 128 + (tid & 127)] = nacc;
        __syncthreads();
        if (tid < 128) NS[w * 128 + tid] = (NR[tid] + NR[128 + tid]) + (NR[256 + tid] + NR[384 + tid]);
    }
}
template <bool HG> __device__ __forceinline__ float gatef_(float g) { const float s = sigmoidf_(g); return HG ? g * s : s; }
template <bool HG> __device__ __forceinline__ void phase_lin_C2(const Params& P, unsigned char* smem) {
    unsigned char* ws = P.ws;
    const bf16_t* __restrict__ PJ = (const bf16_t*)(ws + OFF_HP); bf16_t* __restrict__ Y = (bf16_t*)(ws + OFF_Y);
    const float* __restrict__ NUML = (const float*)(ws + OFF_OLOC); const float* __restrict__ DENL = (const float*)(ws + OFF_DENL); const float* __restrict__ CUMF = (const float*)(ws + OFF_CUMF);
    const float* __restrict__ ST = (const float*)(ws + OFF_ST); const float* __restrict__ NS = (const float*)(ws + OFF_NS);
    const int tid = ltid(), wave = tid >> 6, lane = tid & 63, li = lane & 15, quad = lane >> 4;
    unsigned char* CTl = smem; unsigned char* Ql = smem + 128 * MB_S; float* NP = (float*)(smem + 2 * 128 * MB_S);
    const float qscale = 0.08838834764831845f;
    const int sr = tid >> 4, sc16 = tid & 15;
    constexpr int LDP = HG ? NAB : NCD;
    const float* gain_ = HG ? P.hg_norm : P.ml_norm;
    for (int w = blockIdx.x; w < 256; w += gridDim.x) {
        const int b = w >> 7, h = (w >> 5) & 3, p = w & 31;
        const size_t row0 = (size_t)b * SEQ_ + p * 256;
        __syncthreads();
#pragma unroll
        for (int i = 0; i < 4; ++i) {
            const float* sp = ST + (size_t)w * 16384 + (sr + 32 * i) * 128 + sc16 * 8;
            const f32x4 a = *(const f32x4*)sp, c = *(const f32x4*)(sp + 4);
            u32x4 pw; pw.x = cvt_pk_bf16(a[0], a[1]); pw.y = cvt_pk_bf16(a[2], a[3]); pw.z = cvt_pk_bf16(c[0], c[1]); pw.w = cvt_pk_bf16(c[2], c[3]);
            *(u32x4*)(CTl + (sr + 32 * i) * MB_S + sc16 * 16) = pw;
        }
        if (!HG) { if (tid < 128) NP[tid] = NS[w * 128 + tid]; }
#pragma unroll 1
        for (int qt = 0; qt < 2; ++qt) {
            __syncthreads();
#pragma unroll
            for (int i = 0; i < 4; ++i) *(u32x4*)(Ql + (sr + 32 * i) * MB_S + sc16 * 16) = *(const u32x4*)(PJ + (row0 + qt * 128 + sr + 32 * i) * LDP + h * 128 + sc16 * 8);
            const size_t row = row0 + qt * 128 + wave * 16 + li;
            f32x4 nlv[8]; u32x2 gwv[8]; float cf_raw = 1.0f, den_raw = 0.f;
#pragma unroll
            for (int vt = 0; vt < 8; ++vt) { nlv[vt] = *(const f32x4*)(NUML + row * 512 + h * 128 + vt * 16 + quad * 4); gwv[vt] = *(const u32x2*)(PJ + row * LDP + 1536 + h * 128 + vt * 16 + quad * 4); }
            if (!HG) { cf_raw = CUMF[row * 4 + h]; den_raw = DENL[row * 4 + h]; }
            __syncthreads();
            bf16x8 qf[4];
#pragma unroll
            for (int kc = 0; kc < 4; ++kc) qf[kc] = *(const bf16x8*)(Ql + (wave * 16 + li) * MB_S + (kc * 32 + quad * 8) * 2);
            f32x4 O[8];
#pragma unroll
            for (int vt = 0; vt < 8; ++vt) {
                f32x4 acc = (f32x4){0.f, 0.f, 0.f, 0.f};
#pragma unroll
                for (int kc = 0; kc < 4; ++kc) {
                    const bf16x8 cf_ = *(const bf16x8*)(CTl + (vt * 16 + li) * MB_S + (kc * 32 + quad * 8) * 2);
                    acc = __builtin_amdgcn_mfma_f32_16x16x32_bf16(cf_, qf[kc], acc, 0, 0, 0);
                }
                O[vt] = acc;
            }
            float dc = 0.f;
            if (!HG) {
#pragma unroll
            for (int e = 0; e < 4; ++e) {
                const u32x4 qw = *(const u32x4*)(Ql + (wave * 16 + li) * MB_S + (quad * 32 + e * 8) * 2);
                const float* np_ = NP + quad * 32 + e * 8;
                dc += __uint_as_float(qw.x << 16) * np_[0] + __uint_as_float(qw.x & 0xFFFF0000u) * np_[1] + __uint_as_float(qw.y << 16) * np_[2] + __uint_as_float(qw.y & 0xFFFF0000u) * np_[3]
                    + __uint_as_float(qw.z << 16) * np_[4] + __uint_as_float(qw.z & 0xFFFF0000u) * np_[5] + __uint_as_float(qw.w << 16) * np_[6] + __uint_as_float(qw.w & 0xFFFF0000u) * np_[7];
            }
            dc += __shfl_xor(dc, 16); dc += __shfl_xor(dc, 32);
            }
            float cfq = 1.0f, invd = 1.0f;
            if (!HG) { cfq = cf_raw * qscale; const float den = den_raw + cfq * dc; invd = 1.0f / fmaxf(fabsf(den), 1.0f); }
            float ssq = 0.f;
#pragma unroll
            for (int vt = 0; vt < 8; ++vt) {
                const f32x4 nl = nlv[vt];
                const f32x4 hv = (nl + O[vt] * cfq) * invd;
                O[vt] = hv; ssq += (hv[0] * hv[0] + hv[1] * hv[1]) + (hv[2] * hv[2] + hv[3] * hv[3]);
            }
            ssq += __shfl_xor(ssq, 16); ssq += __shfl_xor(ssq, 32);
            const float rs = rsqrtf(ssq * (1.0f / 128.0f) + EPS_);
#pragma unroll
            for (int vt = 0; vt < 8; ++vt) {
                const int col = h * 128 + vt * 16 + quad * 4;
                const u32x2 gw = gwv[vt];
                const f32x4 gn = *(const f32x4*)(gain_ + col);
                const float y0 = O[vt][0] * rs * gn[0] * gatef_<HG>(__uint_as_float(gw.x << 16)), y1 = O[vt][1] * rs * gn[1] * gatef_<HG>(__uint_as_float(gw.x & 0xFFFF0000u));
                const float y2 = O[vt][2] * rs * gn[2] * gatef_<HG>(__uint_as_float(gw.y << 16)), y3 = O[vt][3] * rs * gn[3] * gatef_<HG>(__uint_as_float(gw.y & 0xFFFF0000u));
                u32x2 yw; yw.x = cvt_pk_bf16(y0, y1); yw.y = cvt_pk_bf16(y2, y3);
                *(u32x2*)(Y + row * D_ + col) = yw;
            }
        }
    }
}

constexpr int HG_S2 = 80;
constexpr int HG_OFF_Q = 0, HG_OFF_K = 32 * MB_S, HG_OFF_KT = 2 * 32 * MB_S, HG_OFF_VT = HG_OFF_KT + 128 * HG_S2, HG_OFF_SW = HG_OFF_VT + 128 * HG_S2, HG_OFF_TAB = HG_OFF_SW + 8 * 16 * MB_S;
__device__ __forceinline__ void phase_hgrn_A2(const Params& P, unsigned char* smem) {
    unsigned char* ws = P.ws;
    bf16_t* PJ = (bf16_t*)(ws + OFF_HP); const float* LB = (const float*)(ws + OFF_LB);
    float* OLOC = (float*)(ws + OFF_OLOC); float* ST = (float*)(ws + OFF_ST); float* DEC = (float*)(ws + OFF_DEC);
    const int tid = ltid(), wave = tid >> 6, lane = tid & 63, li = lane & 15, quad = lane >> 4;
    unsigned char* Ql = smem + HG_OFF_Q; unsigned char* Kl = smem + HG_OFF_K; unsigned char* KT2 = smem + HG_OFF_KT; unsigned char* VTl = smem + HG_OFF_VT;
    unsigned char* SWw = smem + HG_OFF_SW + wave * 16 * MB_S;
    float* Eend = (float*)(smem + HG_OFF_TAB); float* GT = Eend + 128;
    const int d = tid & 127, tg = tid >> 7;
    const int tr = tid & 31, tc16 = tid >> 5;
    for (int w = blockIdx.x; w < 256; w += gridDim.x) {
        const int b = w >> 7, h = (w >> 5) & 3, p = w & 31;
        const size_t row0 = (size_t)b * SEQ_ + p * 256;
        const float lbv = LB[h * 128 + d];
        float Bstart = 0.f;
        f32x4 SA[8];
#pragma unroll
        for (int dt = 0; dt < 8; ++dt) SA[dt] = (f32x4){0.f, 0.f, 0.f, 0.f};
        __syncthreads();
        for (int i = lane; i < 16 * MB_S / 16; i += 64) ((u32x4*)SWw)[i] = (u32x4){0u, 0u, 0u, 0u};
        asm volatile("s_waitcnt lgkmcnt(0)" ::: "memory");
        bf16_t rq[8], rf[8]; u32x4 rv;
        {
            const bf16_t* base = PJ + (row0 + tg * 8) * NAB + h * 128 + d;
#pragma unroll
            for (int e = 0; e < 8; ++e) { rq[e] = base[(size_t)e * NAB]; rf[e] = base[(size_t)e * NAB + 512]; }
            rv = *(const u32x4*)(PJ + (row0 + tr) * NAB + 1024 + h * 128 + tc16 * 8);
        }
#pragma unroll 1
        for (int c = 0; c < 8; ++c) {
            float qs[8], kk[8], cb[8]; float run = 0.f;
#pragma unroll
            for (int e = 0; e < 8; ++e) {
                const float f = lbv + (1.f - lbv) * sigmoidf_(bf2f(rf[e]));
                run += __logf(f); cb[e] = run; kk[e] = 1.f - f;
                const float q = bf2f(rq[e]); qs[e] = q * sigmoidf_(q);
            }
            lds_barrier();
            GT[tg * 128 + d] = run;
            {
                unsigned char* vp = VTl + (tc16 * 8) * HG_S2 + tr * 2;
                *(bf16_t*)(vp) = (bf16_t)(rv.x & 0xFFFFu); *(bf16_t*)(vp + HG_S2) = (bf16_t)(rv.x >> 16);
                *(bf16_t*)(vp + 2 * HG_S2) = (bf16_t)(rv.y & 0xFFFFu); *(bf16_t*)(vp + 3 * HG_S2) = (bf16_t)(rv.y >> 16);
                *(bf16_t*)(vp + 4 * HG_S2) = (bf16_t)(rv.z & 0xFFFFu); *(bf16_t*)(vp + 5 * HG_S2) = (bf16_t)(rv.z >> 16);
                *(bf16_t*)(vp + 6 * HG_S2) = (bf16_t)(rv.w & 0xFFFFu); *(bf16_t*)(vp + 7 * HG_S2) = (bf16_t)(rv.w >> 16);
            }
            lds_barrier();
            const float g0 = GT[d], g1 = GT[128 + d], g2 = GT[256 + d], g3 = GT[384 + d];
            const float pre = (tg > 0 ? g0 : 0.f) + (tg > 1 ? g1 : 0.f) + (tg > 2 ? g2 : 0.f), bend = (g0 + g1) + (g2 + g3);
            const size_t rsub = row0 + c * 32;
            const float ebend = __expf(bend), ebst = __expf(Bstart);
#pragma unroll
            for (int e = 0; e < 8; ++e) {
                const int t = tg * 8 + e; const float bt = pre + cb[e];
                const float ep = __expf(bt), en = __expf(-bt);
                const float qd = qs[e] * ep, kd = kk[e] * en;
                *(bf16_t*)(Ql + t * MB_S + d * 2) = f2bf(qd);
                *(bf16_t*)(Kl + t * MB_S + d * 2) = f2bf(kd);
                *(bf16_t*)(KT2 + d * HG_S2 + t * 2) = f2bf(kd * ebend);
                PJ[(rsub + t) * NAB + h * 128 + d] = f2bf(qd * ebst);
            }
            if (tg == 0) Eend[d] = ebend;
            Bstart += bend;
            if (c < 7) {
                const bf16_t* base = PJ + (rsub + 32 + tg * 8) * NAB + h * 128 + d;
#pragma unroll
                for (int e = 0; e < 8; ++e) { rq[e] = base[(size_t)e * NAB]; rf[e] = base[(size_t)e * NAB + 512]; }
                rv = *(const u32x4*)(PJ + (rsub + 32 + tr) * NAB + 1024 + h * 128 + tc16 * 8);
            }
            lds_barrier();
            bf16x8 qf[2][4];
#pragma unroll
            for (int qt = 0; qt < 2; ++qt)
#pragma unroll
                for (int kc = 0; kc < 4; ++kc) qf[qt][kc] = *(const bf16x8*)(Ql + (qt * 16 + li) * MB_S + (kc * 32 + quad * 8) * 2);
            f32x4 S00 = (f32x4){0.f, 0.f, 0.f, 0.f}, S01 = S00, S11 = S00;
#pragma unroll
            for (int kc = 0; kc < 4; ++kc) {
                const bf16x8 k0 = *(const bf16x8*)(Kl + li * MB_S + (kc * 32 + quad * 8) * 2), k1 = *(const bf16x8*)(Kl + (16 + li) * MB_S + (kc * 32 + quad * 8) * 2);
                S00 = __builtin_amdgcn_mfma_f32_16x16x32_bf16(k0, qf[0][kc], S00, 0, 0, 0);
                S01 = __builtin_amdgcn_mfma_f32_16x16x32_bf16(k0, qf[1][kc], S01, 0, 0, 0);
                S11 = __builtin_amdgcn_mfma_f32_16x16x32_bf16(k1, qf[1][kc], S11, 0, 0, 0);
            }
#pragma unroll
            for (int j = 0; j < 4; ++j) { const bool ok = (quad * 4 + j) <= li; S00[j] = ok ? S00[j] : 0.f; S11[j] = ok ? S11[j] : 0.f; }
            u32x4 pw0, pw1;
            pw0.x = cvt_pk_bf16(S00[0], S00[1]); pw0.y = cvt_pk_bf16(S00[2], S00[3]); pw0.z = 0u; pw0.w = 0u;
            pw1.x = cvt_pk_bf16(S01[0], S01[1]); pw1.y = cvt_pk_bf16(S01[2], S01[3]); pw1.z = cvt_pk_bf16(S11[0], S11[1]); pw1.w = cvt_pk_bf16(S11[2], S11[3]);
            const unsigned char* vrow = VTl + (wave * 16 + li) * HG_S2;
            u32x4 vwi; { const u32x2 lo = *(const u32x2*)(vrow + quad * 8), hi = *(const u32x2*)(vrow + 32 + quad * 8); vwi.x = lo.x; vwi.y = lo.y; vwi.z = hi.x; vwi.w = hi.y; }
            const bf16x8 vfi = __builtin_bit_cast(bf16x8, vwi);
#pragma unroll
            for (int qt = 0; qt < 2; ++qt) {
                f32x4 O = (f32x4){0.f, 0.f, 0.f, 0.f};
#pragma unroll
                for (int kc = 0; kc < 4; ++kc) {
                    const bf16x8 sf = *(const bf16x8*)(SWw + li * MB_S + (kc * 32 + quad * 8) * 2);
                    O = __builtin_amdgcn_mfma_f32_16x16x32_bf16(sf, qf[qt][kc], O, 0, 0, 0);
                }
                O = __builtin_amdgcn_mfma_f32_16x16x32_bf16(vfi, __builtin_bit_cast(bf16x8, qt ? pw1 : pw0), O, 0, 0, 0);
                *(f32x4*)(OLOC + (rsub + qt * 16 + li) * 512 + h * 128 + wave * 16 + quad * 4) = O;
            }
            const bf16x8 vfa = *(const bf16x8*)(vrow + quad * 16);
#pragma unroll
            for (int dt = 0; dt < 8; ++dt) {
                const bf16x8 k2f = *(const bf16x8*)(KT2 + (dt * 16 + li) * HG_S2 + quad * 16);
                const float ee = Eend[dt * 16 + li];
                SA[dt] = __builtin_amdgcn_mfma_f32_16x16x32_bf16(vfa, k2f, SA[dt] * ee, 0, 0, 0);
            }
            asm volatile("s_waitcnt lgkmcnt(0)" ::: "memory");
#pragma unroll
            for (int dt = 0; dt < 8; ++dt)
#pragma unroll
                for (int j = 0; j < 4; ++j) *(bf16_t*)(SWw + (quad * 4 + j) * MB_S + (dt * 16 + li) * 2) = f2bf(SA[dt][j]);
            asm volatile("s_waitcnt lgkmcnt(0)" ::: "memory");
        }
#pragma unroll
        for (int dt = 0; dt < 8; ++dt)
#pragma unroll
            for (int j = 0; j < 4; ++j) ST[(size_t)w * 16384 + (wave * 16 + quad * 4 + j) * 128 + dt * 16 + li] = SA[dt][j];
        if (tg == 0) DEC[w * 128 + d] = __expf(Bstart);
    }
}

__device__ __forceinline__ void phase_final(const Params& P) {
    const float* SS = (const float*)(P.ws + OFF_SS);
    const int wave = ltid() >> 6, lane = ltid() & 63;
    const f32x4* gr = (const f32x4*)P.final_norm;
    f32x4 g[4];
#pragma unroll
    for (int i = 0; i < 4; ++i) g[i] = gr[lane + 64 * i];
    for (int row = (blockIdx.x * 8 + wave) * 2; row < M_; row += gridDim.x * 16) {
        const float rs0 = row_rstd(SS, row), rs1 = row_rstd(SS, row + 1);
        f32x4* x0 = (f32x4*)(P.out + (size_t)row * D_); f32x4* x1 = x0 + D_ / 4;
        f32x4 v0[4], v1[4];
#pragma unroll
        for (int i = 0; i < 4; ++i) { v0[i] = x0[lane + 64 * i]; v1[i] = x1[lane + 64 * i]; }
#pragma unroll
        for (int i = 0; i < 4; ++i) { x0[lane + 64 * i] = v0[i] * rs0 * g[i]; x1[lane + 64 * i] = v1[i] * rs1 * g[i]; }
    }
}

#define XB_TMO      128
#define XB_XCNT(j)  (256  + 64 * (j))
#define XB_XSUB(j)  (1280 + 64 * (j))
#define XB_XGEN(j)  (2304 + 64 * (j))
#define XB_TOP      3328
#define XB_TOPGEN   3392
#define XCD_BAR_WORDS 3456
#define XB_SPIN_CAP (1u << 18)
__device__ __forceinline__ unsigned xb_ld(unsigned* p)              { return __hip_atomic_load(p, __ATOMIC_RELAXED, __HIP_MEMORY_SCOPE_AGENT); }
__device__ __forceinline__ unsigned xb_add(unsigned* p, unsigned v) { return __hip_atomic_fetch_add(p, v, __ATOMIC_RELAXED, __HIP_MEMORY_SCOPE_AGENT); }
__device__ __forceinline__ unsigned xb_xcc_id() { return (unsigned)__builtin_amdgcn_s_getreg((3 << 11) | 20) & 0xFu; }
#define XB_SPIN(cond, bar) do { unsigned _sp = 0; while (cond) { __builtin_amdgcn_s_sleep(1); \
    if ((++_sp & 255u) == 0u) { if (xb_ld(&(bar)[XB_TMO])) break; if (_sp > XB_SPIN_CAP) { atomicAdd(&(bar)[XB_TMO], 1u); break; } } } } while (0)
struct XcdBarrier { unsigned* bar; unsigned x; volatile LAS unsigned* st; };
__device__ __forceinline__ XcdBarrier xcd_barrier_post(unsigned* bar, volatile LAS unsigned* st) {
    XcdBarrier b; b.bar = bar; b.x = xb_xcc_id(); b.st = st;
    if (threadIdx.x == 0) (void)xb_add(&bar[XB_XCNT(b.x)], 1u);
    return b;
}
__device__ __forceinline__ void xcd_barrier_complete(unsigned* bar, unsigned x, unsigned& nloc, unsigned& nx) {
    const unsigned G = gridDim.x * gridDim.y * gridDim.z;
    unsigned sum, cnt, mine, sp = 0u;
    for (;;) {
        sum = 0u; cnt = 0u; mine = 0u;
#pragma unroll
        for (unsigned j = 0; j < 16; ++j) { const unsigned c = xb_ld(&bar[XB_XCNT(j)]); sum += c; cnt += (c > 0u) ? 1u : 0u; mine = (j == x) ? c : mine; }
        if (sum == G) break;
        __builtin_amdgcn_s_sleep(1);
        if ((++sp & 255u) == 0u) { if (xb_ld(&bar[XB_TMO])) break; if (sp > XB_SPIN_CAP) { atomicAdd(&bar[XB_TMO], 1u); break; } }
    }
    nloc = mine > 0u ? mine : 1u; nx = cnt > 0u ? cnt : 1u;
}
__device__ __forceinline__ void xcd_barrier(const XcdBarrier& b) {
    asm volatile("s_waitcnt vmcnt(0)" ::: "memory");
    __syncthreads();
    if (threadIdx.x == 0) {
        unsigned* bar = b.bar;
        __builtin_amdgcn_s_waitcnt(0);
        unsigned nloc = b.st[0], nx = b.st[1];
        if (nloc == 0u) { xcd_barrier_complete(bar, b.x, nloc, nx); b.st[0] = nloc; b.st[1] = nx; }
        const unsigned old = xb_add(&bar[XB_XSUB(b.x)], 1u);
        const unsigned gen = old / nloc;
        if (old + 1u == (gen + 1u) * nloc) {
            __builtin_amdgcn_fence(__ATOMIC_RELEASE, "agent");
            asm volatile("s_waitcnt vmcnt(0)" ::: "memory");
            const unsigned og = xb_add(&bar[XB_TOP], 1u);
            const unsigned tg = og / nx;
            if (og + 1u == (tg + 1u) * nx) xb_add(&bar[XB_TOPGEN], 1u);
            else XB_SPIN(xb_ld(&bar[XB_TOPGEN]) == tg, bar);
            __builtin_amdgcn_fence(__ATOMIC_ACQUIRE, "agent");
            xb_add(&bar[XB_XGEN(b.x)], 1u);
            asm volatile("s_waitcnt vmcnt(0)" ::: "memory");
        } else {
            XB_SPIN(xb_ld(&bar[XB_XGEN(b.x)]) == gen, bar);
            __builtin_amdgcn_fence(__ATOMIC_ACQUIRE, "agent");
            asm volatile("s_waitcnt vmcnt(0)" ::: "memory");
        }
    }
    __syncthreads();
}

constexpr int N_PHASES = 20;
__global__ void __launch_bounds__(512, 2) mk_fwd(Params P0_, int ph_lo, int ph_hi) {
    extern __shared__ __attribute__((aligned(16))) unsigned char smem[];
    LAS unsigned char* lds = (LAS unsigned char*)smem;
    float* L = (float*)smem;
    XcdBarrier xbar; xbar.bar = (unsigned*)(P0_.ws + OFF_BAR); xbar.x = 0; xbar.st = (volatile LAS unsigned*)(lds + LDS_MISC_OFF);
    if (ph_hi - ph_lo > 1) {
        if (threadIdx.x < 2) xbar.st[threadIdx.x] = 0u;
        if (blockIdx.x == 0) { u32x4* bw = (u32x4*)(P0_.ws + OFF_BAR); for (int i = threadIdx.x; i < 16384 / 16; i += 512) bw[i] = (u32x4){0u, 0u, 0u, 0u}; }
        __syncthreads();
    }
    for (int ph = ph_lo; ph < ph_hi; ++ph) {
        Params P = P0_;
        { size_t z_ = 0; asm volatile("" : "+s"(z_));
#define LAUNDER(f) P.f = P0_.f + z_
        LAUNDER(x); LAUNDER(ffn_norm); LAUNDER(ffn_w_in); LAUNDER(ffn_w_out); LAUNDER(mix_norm); LAUNDER(ab_w_in); LAUNDER(ab_w_out); LAUNDER(lb_logits); LAUNDER(hg_norm);
        LAUNDER(conv_w); LAUNDER(conv_b); LAUNDER(cd_w_in); LAUNDER(cd_w_out); LAUNDER(gate_bias); LAUNDER(ml_norm); LAUNDER(final_norm); LAUNDER(out); LAUNDER(ws);
#undef LAUNDER
        }
        unsigned char* ws = P.ws;
        bf16_t* XB = (bf16_t*)(ws + OFF_XB); float* SS = (float*)(ws + OFF_SS); bf16_t* HP = (bf16_t*)(ws + OFF_HP); bf16_t* Y = (bf16_t*)(ws + OFF_Y);
        int kind = -1, widx = 0;
        switch (ph) {
            case 1: kind = 0; widx = 0; break;  case 2: kind = 1; widx = 0; break;
            case 3: kind = 2; widx = 0; break;  case 7: kind = 3; widx = 0; break;
            case 8: kind = 0; widx = 1; break;  case 9: kind = 1; widx = 1; break;
            case 10: kind = 0; widx = 2; break; case 11: kind = 1; widx = 2; break;
            case 12: kind = 2; widx = 1; break; case 16: kind = 3; widx = 1; break;
            case 17: kind = 0; widx = 3; break; case 18: kind = 1; widx = 3; break;
            default: break;
        }
        if (kind == 0) {
            EpiSwiglu E{HP, (const float*)(ws + OFF_RS)};
            run_gemm<EpiSwiglu>(lds, XB, (const bf16_t*)(ws + OFF_W1T + widx * SZ_W1T), NFF1, D_, E, SS, (float*)(ws + OFF_RS), P, smem, ph == 1 ? 1 : (ph == 8 ? 3 : (ph == 10 ? 4 : 0)));
        } else if (kind == 1 || kind == 3) {
            const float* xin = (ph == 2) ? P.x : P.out;
            EpiResid E{xin, P.out, XB, SS, kind == 1 ? 0.5f : 1.0f, ph == 18 ? 0 : 1};
            const bf16_t* A = (kind == 1) ? HP : Y;
            const bf16_t* Bt = (kind == 1) ? (const bf16_t*)(ws + OFF_W2T + widx * SZ_W2T) : (const bf16_t*)(ws + (widx == 0 ? OFF_ABOUT : OFF_CDOUT));
            run_gemm<EpiResid>(lds, A, Bt, D_, kind == 1 ? FF_ : D_, E, nullptr, nullptr, P, smem, 0);
        } else if (kind == 2) {
            EpiProj E{HP, widx == 0 ? NAB : NCD, (const float*)(ws + OFF_RS), widx == 0 ? nullptr : (float*)(ws + OFF_GATES), 3584};
            run_gemm<EpiProj>(lds, XB, (const bf16_t*)(ws + (widx == 0 ? OFF_ABIN : OFF_CDIN)), widx == 0 ? NAB : NCD, D_, E, SS, (float*)(ws + OFF_RS), P, smem, widx == 0 ? 2 : 0);
        } else {
            switch (ph) {
                case 0: phase_prologue(P, L); break;
                case 4: phase_hgrn_A2(P, smem); break;
                case 5: phase_scan((float*)(ws + OFF_ST), (const float*)(ws + OFF_DEC), 1); phase_conv(P); break;
                case 6: phase_lin_C2<true>(P, smem); break;
                case 13: phase_moba_pre(P, L); phase_mlstm_A2(P, smem); break;
                case 14: phase_scan((float*)(ws + OFF_ST), (const float*)(ws + OFF_DSEG), 0); phase_scan_n((float*)(ws + OFF_NS), (const float*)(ws + OFF_DSEG)); __syncthreads(); phase_moba_attn_mfma(P, smem); break;
                case 15: phase_lin_C2<false>(P, smem); break;
                case 19: phase_final(P); break;
                default: break;
            }
        }
        if (ph + 1 < ph_hi) {
            if (ph == 0) { cg::this_grid().sync(); xbar = xcd_barrier_post((unsigned*)(P0_.ws + OFF_BAR), (volatile LAS unsigned*)(lds + LDS_MISC_OFF)); }
            else xcd_barrier(xbar);
        }
    }
}

extern "C" void kernel_launch(void* const* d_in, const int* in_sizes, int n_in, void* d_out, int out_size, void* d_ws, size_t ws_size, hipStream_t stream) {
    static int grid = 0;
    constexpr int LDS_BYTES = LDS_TOTAL;
    if (grid == 0) {
        if (n_in != 16 || in_sizes[0] != M_ * D_ || out_size != M_ * D_ || ws_size < WS_END) { fprintf(stderr, "kernel_launch: unexpected shapes/workspace (n_in %d, ws %zu, need %zu)\n", n_in, ws_size, (size_t)WS_END); grid = -1; return; }
        int dev = 0, cus = 0, per_cu = 0;
        hipGetDevice(&dev); hipDeviceGetAttribute(&cus, hipDeviceAttributeMultiprocessorCount, dev);
        if (hipFuncSetAttribute((const void*)mk_fwd, hipFuncAttributeMaxDynamicSharedMemorySize, LDS_BYTES) != hipSuccess) { fprintf(stderr, "kernel_launch: hipFuncSetAttribute failed\n"); grid = -1; return; }
        if (hipOccupancyMaxActiveBlocksPerMultiprocessor(&per_cu, (const void*)mk_fwd, 512, LDS_BYTES) != hipSuccess || per_cu < 1) { fprintf(stderr, "kernel_launch: occupancy query failed (%d)\n", per_cu); per_cu = 1; }
        (void)hipGetLastError();
        grid = cus * (per_cu > 1 ? 1 : per_cu);
    }
    if (grid < 0) return;
    Params p{};
    p.x = (const float*)d_in[0]; p.ffn_norm = (const float*)d_in[1]; p.ffn_w_in = (const float*)d_in[2]; p.ffn_w_out = (const float*)d_in[3]; p.mix_norm = (const float*)d_in[4];
    p.ab_w_in = (const float*)d_in[5]; p.ab_w_out = (const float*)d_in[6]; p.lb_logits = (const float*)d_in[7]; p.hg_norm = (const float*)d_in[8]; p.conv_w = (const float*)d_in[9]; p.conv_b = (const float*)d_in[10];
    p.cd_w_in = (const float*)d_in[11]; p.cd_w_out = (const float*)d_in[12]; p.gate_bias = (const float*)d_in[13]; p.ml_norm = (const float*)d_in[14]; p.final_norm = (const float*)d_in[15];
    p.out = (float*)d_out; p.ws = (unsigned char*)d_ws;
#if N_LAUNCH_MODE == 1
    int lo = 0, hi = N_PHASES;
    void* args[] = {&p, &lo, &hi};
    hipError_t e = hipLaunchCooperativeKernel((const void*)mk_fwd, dim3(grid), dim3(512), args, LDS_BYTES, stream);
    if (e != hipSuccess) fprintf(stderr, "cooperative launch failed: %s (grid %d)\n", hipGetErrorString(e), grid);
#else
    for (int ph = 0; ph < N_PHASES; ++ph) {
        hipLaunchKernelGGL(mk_fwd, dim3(grid), dim3(512), LDS_BYTES, stream, p, ph, ph + 1);
    }
#endif
}
```

```cpp
#include <hip/hip_runtime.h>
#include <hip/hip_cooperative_groups.h>
#include <cstdio>
#include <cstdint>
namespace cg = cooperative_groups;

#ifndef N_LAUNCH_MODE
#define N_LAUNCH_MODE 1
#endif

#define LAS __attribute__((address_space(3)))
typedef unsigned short bf16_t;
typedef short bf16x8 __attribute__((ext_vector_type(8)));
typedef float f32x4 __attribute__((ext_vector_type(4)));
typedef unsigned u32x4 __attribute__((ext_vector_type(4)));
typedef unsigned u32x2 __attribute__((ext_vector_type(2)));

constexpr int M_ = 16384, D_ = 1024, FF_ = 2816, NFF1 = 5632, NAB = 3584, NCD = 3840, SEQ_ = 8192;
constexpr float EPS_ = 1e-6f;

constexpr size_t SZ_W1T = (size_t)NFF1 * D_ * 2, SZ_W2T = (size_t)D_ * FF_ * 2;
constexpr size_t OFF_W1T = 0;
constexpr size_t OFF_W2T = OFF_W1T + 4 * SZ_W1T;
constexpr size_t OFF_ABIN = OFF_W2T + 4 * SZ_W2T;
constexpr size_t OFF_ABOUT = OFF_ABIN + (size_t)NAB * D_ * 2;
constexpr size_t OFF_CDIN = OFF_ABOUT + (size_t)D_ * D_ * 2;
constexpr size_t OFF_CDOUT = OFF_CDIN + (size_t)NCD * D_ * 2;
constexpr size_t OFF_XB = OFF_CDOUT + (size_t)D_ * D_ * 2;
constexpr size_t OFF_SS = OFF_XB + (size_t)M_ * D_ * 2;
constexpr size_t OFF_GATES = OFF_SS + (size_t)M_ * 16 * 4;
constexpr size_t OFF_HP = OFF_GATES + (size_t)M_ * 8 * 4;
constexpr size_t OFF_Y = OFF_HP + (size_t)M_ * NCD * 2;
constexpr size_t OFF_OLOC = OFF_Y + (size_t)M_ * D_ * 2;
constexpr size_t OFF_ST = OFF_OLOC + (size_t)M_ * 512 * 4;
constexpr size_t OFF_DEC = OFF_ST + (size_t)256 * 16384 * 4;
constexpr size_t OFF_NS = OFF_DEC + (size_t)256 * 128 * 4;
constexpr size_t OFF_DENL = OFF_NS + (size_t)256 * 128 * 4;
constexpr size_t OFF_CUMF = OFF_DENL + (size_t)M_ * 4 * 4;
constexpr size_t OFF_DSEG = OFF_CUMF + (size_t)M_ * 4 * 4;
constexpr size_t OFF_KMEAN = OFF_DSEG + 1024;
constexpr size_t OFF_LB = OFF_KMEAN + (size_t)2 * 4 * 32 * 128 * 4;
constexpr size_t OFF_RS = OFF_LB + 2048;
constexpr size_t OFF_BAR = OFF_RS + (size_t)M_ * 4;
constexpr size_t WS_END = OFF_BAR + 16384;

struct Params {
    const float* x; const float* ffn_norm; const float* ffn_w_in; const float* ffn_w_out; const float* mix_norm;
    const float* ab_w_in; const float* ab_w_out; const float* lb_logits; const float* hg_norm; const float* conv_w; const float* conv_b;
    const float* cd_w_in; const float* cd_w_out; const float* gate_bias; const float* ml_norm; const float* final_norm;
    float* out; unsigned char* ws;
};

__device__ __forceinline__ int ltid() { int t = (int)threadIdx.x; asm volatile("" : "+v"(t)); return t; }
__device__ __forceinline__ float bf2f(unsigned short b) { return __uint_as_float(((unsigned)b) << 16); }
typedef float f32x2_t __attribute__((ext_vector_type(2)));
typedef __bf16 bf16x2_t __attribute__((ext_vector_type(2)));
__device__ __forceinline__ unsigned cvt_pk_bf16(float lo, float hi) { f32x2_t v = {lo, hi}; bf16x2_t b = __builtin_convertvector(v, bf16x2_t); return __builtin_bit_cast(unsigned, b); }
__device__ __forceinline__ unsigned short f2bf(float f) { return (unsigned short)(cvt_pk_bf16(f, 0.f) & 0xFFFFu); }
__device__ __forceinline__ unsigned pk2(float lo, float hi) { return cvt_pk_bf16(lo, hi); }
__device__ __forceinline__ float sigmoidf_(float x) { return __builtin_amdgcn_rcpf(1.0f + __expf(-x)); }
__device__ __forceinline__ void lds_barrier() { asm volatile("s_waitcnt lgkmcnt(0)" ::: "memory"); __builtin_amdgcn_s_barrier(); asm volatile("" ::: "memory"); }
__device__ __forceinline__ float wave_sum(float v) {
#pragma unroll
    for (int o = 32; o >= 1; o >>= 1) v += __shfl_xor(v, o);
    return v;
}
__device__ __forceinline__ float wave_max(float v) {
#pragma unroll
    for (int o = 32; o >= 1; o >>= 1) v = fmaxf(v, __shfl_xor(v, o));
    return v;
}

namespace pg8 {
constexpr int BM = 256, BK = 64, HALF = 128, HTB = HALF * BK * 2, STAGE_BYTES = 8 * HTB, NXCD = 8, WGM = 4;
__host__ __device__ __forceinline__ int lds_byte(int r, int c) { const int st = (r >> 4) * 2 + (c >> 5), rr = r & 15, cc = c & 31, ob = rr * 64 + cc * 2; return st * 1024 + (ob ^ (((ob >> 9) & 1) << 5)); }
__host__ __device__ __forceinline__ void stage_rc(int b, int& R, int& C) { const int st = b / 1024, sb = b % 1024, swz = sb ^ (((sb >> 9) & 1) << 5); R = (st >> 1) * 16 + swz / 64; C = (st & 1) * 32 + (swz % 64) / 2; }
__host__ __device__ __forceinline__ int perm32(int rho) { const int n = rho >> 4, i = rho & 15; return 8 * (i >> 2) + 4 * n + (i & 3); }
struct Unit { int pm, pn; };
struct Gemm { const bf16_t* A; const bf16_t* Bt; int M, N, K; };
struct StaticOrder {
    int nM, nN, nwg, G, c, wgm;
    __host__ __device__ void init(int M, int N, int G_, int c_) { nM = M / BM; nN = N / BM; nwg = nM * nN; G = G_; c = c_; wgm = (nN > 16) ? 4 : 8; }
    __host__ __device__ bool next(int i, Unit& u) const {
        const long L = (long)i * G + c; if (L >= nwg) return false;
        int wgid = (int)L; { const int q = nwg / NXCD, r = nwg % NXCD, xcd = wgid % NXCD, off = wgid / NXCD; wgid = (xcd < r ? xcd * (q + 1) : r * (q + 1) + (xcd - r) * q) + off; }
        const int nig = wgm * nN, gid = wgid / nig, fm = gid * wgm, gsz = (nM - fm) < wgm ? (nM - fm) : wgm;
        u.pm = fm + ((wgid % nig) % gsz); u.pn = (wgid % nig) / gsz; return true;
    }
};

template <class Epi>
__device__ __forceinline__ void gemm_phase(LAS unsigned char* lds, const Gemm g, const StaticOrder& S, const Epi& E) {
    const int tid = ltid(), wid = __builtin_amdgcn_readfirstlane(tid >> 6), lane = tid & 63, wr = wid >> 2, wc = wid & 3, fr = lane & 15, fq = lane >> 4;
    const int K = g.K, nt = K / BK;
    unsigned voffA[2], voffB[2];
#pragma unroll
    for (int i = 0; i < 2; ++i) { int R, C; stage_rc(tid * 16 + i * 8192, R, C); const int Rb = ((R & ~31) + perm32(R & 31));
        voffA[i] = (unsigned)(R * K + C) * 2u; voffB[i] = (unsigned)(Rb * K + C) * 2u; }
    const size_t kstep = (size_t)(BK * 2);
    const size_t hstep = (size_t)HALF * K * 2;
    const size_t tstep = 2 * hstep;
    const unsigned ldsw = (unsigned)wid * 1024u;
    const int aoff = lds_byte(wr * 64 + fr, fq * 8), boff = lds_byte(wc * 32 + fr, fq * 8);
#define PG8_SA(b, h) (((b) * 2 + (h)) * HTB)
#define PG8_SB(b, h) ((4 + (b) * 2 + (h)) * HTB)
#define PG8_STAGE(bufoff, gbase, voff) do { _Pragma("unroll") for (int _i = 0; _i < 2; ++_i) \
        __builtin_amdgcn_global_load_lds((const unsigned*)((const char*)(gbase) + (voff)[_i]), (LAS unsigned*)(lds + (bufoff) + ldsw + _i * 8192), 16, 0, 0); } while (0)
#define PG8_LDA(dst, b, h) do { _Pragma("unroll") for (int m = 0; m < 4; ++m) _Pragma("unroll") for (int k = 0; k < 2; ++k) dst[m][k] = *(const LAS bf16x8*)(lds + PG8_SA(b, h) + aoff + m * 2048 + k * 1024); } while (0)
#define PG8_LDB(dst, b, h) do { _Pragma("unroll") for (int n = 0; n < 2; ++n) _Pragma("unroll") for (int k = 0; k < 2; ++k) dst[n][k] = *(const LAS bf16x8*)(lds + PG8_SB(b, h) + boff + n * 2048 + k * 1024); } while (0)
#define PG8_MMA(ai, bj, At, Bt) do { __builtin_amdgcn_s_setprio(1); _Pragma("unroll") for (int m = 0; m < 4; ++m) _Pragma("unroll") for (int n = 0; n < 2; ++n) _Pragma("unroll") for (int k = 0; k < 2; ++k) \
        acc[ai][bj][m][n] = __builtin_amdgcn_mfma_f32_16x16x32_bf16(Bt[n][k], At[m][k], acc[ai][bj][m][n], 0, 0, 0); __builtin_amdgcn_s_setprio(0); } while (0)
#define PG8_WAIT_V(n) asm volatile("s_waitcnt vmcnt(" #n ")" ::: "memory")
#define PG8_WAIT_L(n) asm volatile("s_waitcnt lgkmcnt(" #n ")" ::: "memory")
#define PG8_BAR __builtin_amdgcn_s_barrier()
#define PG8_SCHED __builtin_amdgcn_sched_barrier(0)
    Unit cur, nxt; int ui = 0;
    if (!S.next(0, cur)) return;
    f32x4 acc[2][2][4][2];
#pragma unroll
    for (int a = 0; a < 2; ++a)
#pragma unroll
        for (int b = 0; b < 2; ++b)
#pragma unroll
            for (int m = 0; m < 4; ++m)
#pragma unroll
                for (int n = 0; n < 2; ++n) acc[a][b][m][n] = (f32x4){0.f, 0.f, 0.f, 0.f};
    bf16x8 At[4][2], B0[2][2], B1[2][2];
    const char* cA = (const char*)g.A + (size_t)cur.pm * tstep; const char* cB = (const char*)g.Bt + (size_t)cur.pn * tstep;
    typename Epi::Pre epre = E.prefetch(cur, wr, fr);
    PG8_STAGE(PG8_SB(0, 0), cB, voffB); PG8_STAGE(PG8_SB(0, 1), cB + hstep, voffB); PG8_STAGE(PG8_SA(0, 0), cA, voffA); PG8_STAGE(PG8_SA(0, 1), cA + hstep, voffA);
    if (wr == 1) PG8_BAR;
    PG8_WAIT_V(2); PG8_BAR;
    PG8_STAGE(PG8_SB(1, 0), cB + kstep, voffB); PG8_STAGE(PG8_SA(1, 0), cA + kstep, voffA); PG8_STAGE(PG8_SB(1, 1), cB + hstep + kstep, voffB);
    PG8_WAIT_V(6); PG8_BAR;
    for (;;) {
        const bool has_next = S.next(ui + 1, nxt);
        const char* nA = has_next ? (const char*)g.A + (size_t)nxt.pm * tstep : cA; const char* nB = has_next ? (const char*)g.Bt + (size_t)nxt.pn * tstep : cB;
        for (int t = 0; t < nt; t += 2) {
            const bool last = (t == nt - 2);
            const char* a1 = cA + (size_t)(t + 1) * kstep;
            const char* a2 = last ? nA : cA + (size_t)(t + 2) * kstep; const char* b2 = last ? nB : cB + (size_t)(t + 2) * kstep;
            const char* a3 = a2 + kstep; const char* b3 = b2 + kstep;
            PG8_LDB(B0, 0, 0); PG8_LDB(B1, 0, 1); PG8_SCHED; PG8_LDA(At, 0, 0); PG8_STAGE(PG8_SA(1, 1), a1 + hstep, voffA);
            PG8_WAIT_V(8); PG8_WAIT_L(0); PG8_BAR; PG8_MMA(0, 0, At, B0); PG8_MMA(0, 1, At, B1); PG8_BAR; PG8_SCHED;
            PG8_LDA(At, 0, 1); PG8_STAGE(PG8_SB(0, 0), b2, voffB); PG8_STAGE(PG8_SB(0, 1), b2 + hstep, voffB); PG8_STAGE(PG8_SA(0, 0), a2, voffA);
            PG8_WAIT_V(8); PG8_WAIT_L(0); PG8_BAR; PG8_MMA(1, 0, At, B0); PG8_MMA(1, 1, At, B1); PG8_BAR; PG8_SCHED;
            PG8_LDB(B0, 1, 0); PG8_LDB(B1, 1, 1); PG8_SCHED; PG8_LDA(At, 1, 0); PG8_STAGE(PG8_SA(0, 1), a2 + hstep, voffA);
            PG8_WAIT_V(8); PG8_WAIT_L(0); PG8_BAR; PG8_MMA(0, 0, At, B0); PG8_MMA(0, 1, At, B1); PG8_BAR; PG8_SCHED;
            PG8_LDA(At, 1, 1); PG8_STAGE(PG8_SB(1, 0), b3, voffB); PG8_STAGE(PG8_SB(1, 1), b3 + hstep, voffB); PG8_STAGE(PG8_SA(1, 0), a3, voffA);
            PG8_WAIT_V(8); PG8_WAIT_L(0); PG8_BAR; PG8_MMA(1, 0, At, B0); PG8_MMA(1, 1, At, B1); PG8_BAR; PG8_SCHED;
        }
        if (wr == 0) PG8_BAR;
        E(acc, cur, wr, wc, fr, fq, epre);
        if (!has_next) break;
#pragma unroll
        for (int a = 0; a < 2; ++a)
#pragma unroll
            for (int b = 0; b < 2; ++b)
#pragma unroll
                for (int m = 0; m < 4; ++m)
#pragma unroll
                    for (int n = 0; n < 2; ++n) acc[a][b][m][n] = (f32x4){0.f, 0.f, 0.f, 0.f};
        cur = nxt; cA = nA; cB = nB; ++ui;
        epre = E.prefetch(cur, wr, fr);
        if (wr == 1) PG8_BAR;
    }
    PG8_WAIT_V(0);
    PG8_BAR;
#undef PG8_SA
#undef PG8_SB
#undef PG8_STAGE
#undef PG8_LDA
#undef PG8_LDB
#undef PG8_MMA
#undef PG8_WAIT_V
#undef PG8_WAIT_L
#undef PG8_BAR
#undef PG8_SCHED
}
}

__device__ __forceinline__ float row_rstd(const float* ss, int row) {
    const f32x4* sp = (const f32x4*)(ss + (size_t)row * 16);
    const f32x4 a = sp[0], b = sp[1], c = sp[2], d = sp[3];
    const float s = ((a[0] + a[1]) + (a[2] + a[3])) + ((b[0] + b[1]) + (b[2] + b[3])) + ((c[0] + c[1]) + (c[2] + c[3])) + ((d[0] + d[1]) + (d[2] + d[3]));
    return rsqrtf(s * (1.0f / D_) + EPS_);
}

struct EpiSwiglu {
    bf16_t* H; const float* rsv;
    struct Pre { float r[8]; };
    __device__ __forceinline__ Pre prefetch(const pg8::Unit& u, int wr, int fr) const {
        Pre p; const int row0 = u.pm * 256 + wr * 64 + fr;
#pragma unroll
        for (int i = 0; i < 8; ++i) p.r[i] = rsv[row0 + (i >> 2) * 128 + (i & 3) * 16];
        return p;
    }
    __device__ __forceinline__ void operator()(const f32x4 (&acc)[2][2][4][2], const pg8::Unit& u, int wr, int wc, int fr, int fq, const Pre& pre) const {
        const int row0 = u.pm * 256 + wr * 64 + fr, col0 = u.pn * 128 + wc * 32 + 8 * fq;
#pragma unroll
        for (int ai = 0; ai < 2; ++ai)
#pragma unroll
            for (int m = 0; m < 4; ++m) {
                const int row = row0 + ai * 128 + m * 16;
                const float rs = pre.r[ai * 4 + m], rs2 = rs * rs, nrl = rs * -1.4426950408889634f;
                float hv[8];
#pragma unroll
                for (int n = 0; n < 2; ++n)
#pragma unroll
                    for (int j = 0; j < 4; ++j) { const float ag = acc[ai][0][m][n][j], au = acc[ai][1][m][n][j]; hv[n * 4 + j] = (ag * au) * rs2 * __builtin_amdgcn_rcpf(1.0f + __builtin_amdgcn_exp2f(ag * nrl)); }
                u32x4 w; w.x = pk2(hv[0], hv[1]); w.y = pk2(hv[2], hv[3]); w.z = pk2(hv[4], hv[5]); w.w = pk2(hv[6], hv[7]);
                *(u32x4*)(H + (size_t)row * FF_ + col0) = w;
            }
    }
};
struct EpiResid {
    const float* Xin; float* Xout; bf16_t* XB; float* ss; float scale; int write_xb;
    struct Pre {};
    __device__ __forceinline__ Pre prefetch(const pg8::Unit&, int, int) const { return Pre{}; }
    __device__ __forceinline__ void operator()(const f32x4 (&acc)[2][2][4][2], const pg8::Unit& u, int wr, int wc, int fr, int fq, const Pre&) const {
        const int row0 = u.pm * 256 + wr * 64 + fr, col0 = u.pn * 256 + wc * 32 + 8 * fq;
        f32x4 xw[3][2][2];
#define ER_LOAD(s_) do { const size_t o_ = (size_t)(row0 + ((s_) >> 2) * 128 + ((s_) & 3) * 16) * D_ + col0; _Pragma("unroll") for (int bj = 0; bj < 2; ++bj) { \
            xw[(s_) % 3][bj][0] = *(const f32x4*)(Xin + o_ + bj * 128); xw[(s_) % 3][bj][1] = *(const f32x4*)(Xin + o_ + bj * 128 + 4); } } while (0)
        ER_LOAD(0); ER_LOAD(1);
#pragma unroll
        for (int s = 0; s < 8; ++s) {
            if (s + 2 < 8) ER_LOAD(s + 2);
            const int ai = s >> 2, m = s & 3;
            const int row = row0 + ai * 128 + m * 16;
            float sq = 0.f;
#pragma unroll
            for (int bj = 0; bj < 2; ++bj) {
                const size_t o = (size_t)row * D_ + col0 + bj * 128;
                const f32x4 x0 = xw[s % 3][bj][0] + acc[ai][bj][m][0] * scale, x1 = xw[s % 3][bj][1] + acc[ai][bj][m][1] * scale;
                __builtin_nontemporal_store(x0, (f32x4*)(Xout + o)); __builtin_nontemporal_store(x1, (f32x4*)(Xout + o + 4));
                u32x4 w; w.x = pk2(x0[0], x0[1]); w.y = pk2(x0[2], x0[3]); w.z = pk2(x1[0], x1[1]); w.w = pk2(x1[2], x1[3]);
                if (write_xb) *(u32x4*)(XB + o) = w;
                sq += (x0[0] * x0[0] + x0[1] * x0[1]) + (x0[2] * x0[2] + x0[3] * x0[3]) + (x1[0] * x1[0] + x1[1] * x1[1]) + (x1[2] * x1[2] + x1[3] * x1[3]);
            }
            sq += __shfl_xor(sq, 16); sq += __shfl_xor(sq, 32);
            if (fq == 0) ss[(size_t)row * 16 + u.pn * 4 + wc] = sq;
        }
#undef ER_LOAD
    }
};
struct EpiProj {
    bf16_t* Pj; int ldp; const float* rsv; float* gates; int gate_col0;
    struct Pre { float r[8]; };
    __device__ __forceinline__ Pre prefetch(const pg8::Unit& u, int wr, int fr) const {
        Pre p; const int row0 = u.pm * 256 + wr * 64 + fr;
#pragma unroll
        for (int i = 0; i < 8; ++i) p.r[i] = rsv[row0 + (i >> 2) * 128 + (i & 3) * 16];
        return p;
    }
    __device__ __forceinline__ void operator()(const f32x4 (&acc)[2][2][4][2], const pg8::Unit& u, int wr, int wc, int fr, int fq, const Pre& pre) const {
        const int row0 = u.pm * 256 + wr * 64 + fr, col0 = u.pn * 256 + wc * 32 + 8 * fq;
#pragma unroll
        for (int ai = 0; ai < 2; ++ai)
#pragma unroll
            for (int m = 0; m < 4; ++m) {
                const int row = row0 + ai * 128 + m * 16;
                const float rs = pre.r[ai * 4 + m];
#pragma unroll
                for (int bj = 0; bj < 2; ++bj) {
                    const f32x4 v0 = acc[ai][bj][m][0] * rs, v1 = acc[ai][bj][m][1] * rs;
                    u32x4 w; w.x = pk2(v0[0], v0[1]); w.y = pk2(v0[2], v0[3]); w.z = pk2(v1[0], v1[1]); w.w = pk2(v1[2], v1[3]);
                    if (col0 + bj * 128 < 3584) *(u32x4*)(Pj + (size_t)row * ldp + col0 + bj * 128) = w;
                    if (gates != nullptr && bj == 0 && col0 == gate_col0) { *(f32x4*)(gates + (size_t)row * 8) = v0; *(f32x4*)(gates + (size_t)row * 8 + 4) = v1; }
                }
            }
    }
};

struct ConvJob { const float* W; const float* gain; bf16_t* out; int ldw, K, k0, n0, mode; };
constexpr int T_W1 = 16 * 44, T_W2 = 44 * 8, T_ABI = 16 * 28, T_SQ = 16 * 8, T_CDI = 16 * 30;
__host__ __device__ constexpr int conv_ntiles(int m) { return m < 0 ? 0 : (m < 4 ? T_W1 : (m < 8 ? T_W2 : (m == 8 ? T_ABI : (m == 10 ? T_CDI : T_SQ)))); }
__device__ __forceinline__ ConvJob conv_decode_m(const Params& P, int m, int t) {
    ConvJob j; unsigned char* ws = P.ws; int ntn;
    if (m < 4) { j.W = P.ffn_w_in + (size_t)m * D_ * NFF1; j.gain = P.ffn_norm + (size_t)m * D_; j.out = (bf16_t*)(ws + OFF_W1T + m * SZ_W1T); j.ldw = NFF1; j.K = D_; j.mode = 1; ntn = 44; }
    else if (m < 8) { const int i = m - 4; j.W = P.ffn_w_out + (size_t)i * FF_ * D_; j.gain = nullptr; j.out = (bf16_t*)(ws + OFF_W2T + i * SZ_W2T); j.ldw = D_; j.K = FF_; j.mode = 0; ntn = 8; }
    else if (m == 8) { j.W = P.ab_w_in; j.gain = P.mix_norm; j.out = (bf16_t*)(ws + OFF_ABIN); j.ldw = NAB; j.K = D_; j.mode = 0; ntn = 28; }
    else if (m == 9) { j.W = P.ab_w_out; j.gain = nullptr; j.out = (bf16_t*)(ws + OFF_ABOUT); j.ldw = D_; j.K = D_; j.mode = 0; ntn = 8; }
    else if (m == 10) { j.W = P.cd_w_in; j.gain = P.mix_norm + D_; j.out = (bf16_t*)(ws + OFF_CDIN); j.ldw = 3592; j.K = D_; j.mode = 2; ntn = 30; }
    else { j.W = P.cd_w_out; j.gain = nullptr; j.out = (bf16_t*)(ws + OFF_CDOUT); j.ldw = D_; j.K = D_; j.mode = 0; ntn = 8; }
    j.k0 = (t / ntn) * 64; j.n0 = (t % ntn) * 128;
    return j;
}
__device__ __forceinline__ void conv_load(const ConvJob& j, int tid, f32x4 (&r)[4]) {
#pragma unroll
    for (int i = 0; i < 4; ++i) {
        const int c = tid + 512 * i, kk = c >> 5, n4 = (c & 31) * 4, nn = n4 & 63, n0h = j.n0 + (n4 & 64);
        int src0 = n0h, cnt = 64;
        if (j.mode == 1) { const int pn = n0h >> 8, within = n0h & 255, bj = within >> 7, off = within & 127; src0 = bj * FF_ + pn * 128 + off; }
        else if (j.mode == 2) { if (n0h < 2048) src0 = n0h; else if (n0h < 3584) src0 = n0h + 8; else if (n0h == 3584) { src0 = 2048; cnt = 8; } else { src0 = 0; cnt = 0; } }
        f32x4 v = (f32x4){0.f, 0.f, 0.f, 0.f};
        if (nn < cnt) { v = *(const f32x4*)(j.W + (size_t)(j.k0 + kk) * j.ldw + src0 + nn); if (j.gain) v = v * j.gain[j.k0 + kk]; }
        r[i] = v;
    }
}
template <int M0, int M1, int M2, int M3>
__device__ __forceinline__ void conv_batch(const Params& P, float* tile, int worker, int nworkers) {
    constexpr int n0 = conv_ntiles(M0), n1 = n0 + conv_ntiles(M1), n2 = n1 + conv_ntiles(M2), n3 = n2 + conv_ntiles(M3);
    const int tid = ltid();
    int t = worker;
    if (t >= n3) return;
#define CONV_DEC(t_) ((t_) < n0 ? conv_decode_m(P, M0, (t_)) : ((t_) < n1 ? conv_decode_m(P, M1, (t_) - n0) : ((t_) < n2 ? conv_decode_m(P, M2, (t_) - n1) : conv_decode_m(P, M3, (t_) - n2))))
    ConvJob j = CONV_DEC(t);
    f32x4 r[4];
    conv_load(j, tid, r);
    for (;;) {
#pragma unroll
        for (int i = 0; i < 4; ++i) { const int c = tid + 512 * i, kk = c >> 5, n4 = (c & 31) * 4; float* tp = tile + kk * 129 + n4; tp[0] = r[i][0]; tp[1] = r[i][1]; tp[2] = r[i][2]; tp[3] = r[i][3]; }
        const ConvJob cur = j;
        const int tn = t + nworkers; const bool more = tn < n3;
        if (more) { j = CONV_DEC(tn); conv_load(j, tid, r); }
        __syncthreads();
        {
            const int nn = tid >> 2, kq = (tid & 3) * 16;
            const float* tp = tile + kq * 129 + nn;
            u32x4 w0, w1;
            w0.x = pk2(tp[0 * 129], tp[1 * 129]); w0.y = pk2(tp[2 * 129], tp[3 * 129]); w0.z = pk2(tp[4 * 129], tp[5 * 129]); w0.w = pk2(tp[6 * 129], tp[7 * 129]);
            w1.x = pk2(tp[8 * 129], tp[9 * 129]); w1.y = pk2(tp[10 * 129], tp[11 * 129]); w1.z = pk2(tp[12 * 129], tp[13 * 129]); w1.w = pk2(tp[14 * 129], tp[15 * 129]);
            bf16_t* op = cur.out + (size_t)(cur.n0 + nn) * cur.K + cur.k0 + kq;
            *(u32x4*)op = w0; *(u32x4*)(op + 8) = w1;
        }
        __syncthreads();
        if (!more) break;
        t = tn;
    }
#undef CONV_DEC
}
template <class Epi> __device__ __forceinline__ void run_gemm(LAS unsigned char* lds, const bf16_t* A, const bf16_t* Bt, int N, int K, const Epi& E, const float* ss, float* rsv, const Params& P, unsigned char* lds_generic, int cbatch) {
    pg8::Gemm g{A, Bt, M_, N, K}; pg8::StaticOrder S; S.init(M_, N, (int)gridDim.x, (int)blockIdx.x);
    if (rsv != nullptr) {
        const int tid = ltid(), r = tid >> 1, hsel = tid & 1;
        f32x4 pa[8], pb[8]; unsigned okm = 0u; int rows[8];
#pragma unroll
        for (int i = 0; i < 8; ++i) {
            pg8::Unit u; const bool ok = S.next(i, u);
            rows[i] = ok ? u.pm * 256 + r : r;
            const f32x4* sp = (const f32x4*)(ss + (size_t)rows[i] * 16 + hsel * 8);
            pa[i] = sp[0]; pb[i] = sp[1];
            okm |= ok ? (1u << i) : 0u;
        }
#pragma unroll
        for (int i = 0; i < 8; ++i) {
            float s = ((pa[i][0] + pa[i][1]) + (pa[i][2] + pa[i][3])) + ((pb[i][0] + pb[i][1]) + (pb[i][2] + pb[i][3]));
            s += __shfl_xor(s, 1);
            if (hsel == 0 && ((okm >> i) & 1u)) rsv[rows[i]] = rsqrtf(s * (1.0f / D_) + EPS_);
        }
        __syncthreads();
    }
    pg8::gemm_phase<Epi>(lds, g, S, E);
    if (cbatch != 0) {
        const int r = S.nwg % S.G;
        if (r != 0 && (int)blockIdx.x >= r) {
            float* tile = (float*)(const_cast<unsigned char*>((const unsigned char*)lds_generic));
            const int worker = (int)blockIdx.x - r, nworkers = S.G - r;
            if (cbatch == 1) conv_batch<1, 5, -1, -1>(P, tile, worker, nworkers);
            else if (cbatch == 2) conv_batch<9, 2, 11, -1>(P, tile, worker, nworkers);
            else if (cbatch == 3) conv_batch<6, 10, 7, -1>(P, tile, worker, nworkers);
            else conv_batch<3, -1, -1, -1>(P, tile, worker, nworkers);
        }
    }
}

__device__ __forceinline__ void phase_prologue(const Params& P, float* L) {
    const int tid = ltid(), bid = blockIdx.x, nb = gridDim.x, wave = tid >> 6, lane = tid & 63;
    unsigned char* ws = P.ws;
    {
        bf16_t* __restrict__ XB = (bf16_t*)(ws + OFF_XB); float* __restrict__ SS = (float*)(ws + OFF_SS); const float* __restrict__ xin_ = P.x;
        for (int row = bid * 8 + wave; row < M_; row += nb * 8) {
            const f32x4* xr = (const f32x4*)(xin_ + (size_t)row * D_);
            float sq = 0.f;
#pragma unroll
            for (int i = 0; i < 4; ++i) {
                const f32x4 v = xr[lane + 64 * i];
                sq += (v[0] * v[0] + v[1] * v[1]) + (v[2] * v[2] + v[3] * v[3]);
                u32x2 pk; pk.x = pk2(v[0], v[1]); pk.y = pk2(v[2], v[3]);
                *(u32x2*)(XB + (size_t)row * D_ + (lane + 64 * i) * 4) = pk;
            }
            sq = wave_sum(sq);
            if (lane < 16) SS[(size_t)row * 16 + lane] = (lane == 0) ? sq : 0.f;
        }
    }
    conv_batch<0, 4, 8, -1>(P, L, (int)blockIdx.x, (int)gridDim.x);
    if (bid == 0) {
        float* LB = (float*)(ws + OFF_LB);
        const float l0 = P.lb_logits[tid], l1 = P.lb_logits[512 + tid], l2 = P.lb_logits[1024 + tid];
        const float mx = fmaxf(l0, fmaxf(l1, l2)), e0 = __expf(l0 - mx), e1 = __expf(l1 - mx), e2 = __expf(l2 - mx);
        LB[tid] = e0 / (e0 + e1 + e2);
    }
}

__device__ __forceinline__ void phase_conv(const Params& P) {
    const bf16_t* __restrict__ PJ = (const bf16_t*)(P.ws + OFF_HP); bf16_t* __restrict__ Y = (bf16_t*)(P.ws + OFF_Y);
    const int ch = ltid();
    const float w0 = P.conv_w[ch], w1 = P.conv_w[512 + ch], w2 = P.conv_w[1024 + ch], cb = P.conv_b[ch];
    for (int blk = blockIdx.x; blk < M_ / 64; blk += gridDim.x) {
        const int r0 = blk * 64;
        float z2 = 0.f, z1 = 0.f;
        if ((r0 & (SEQ_ - 1)) != 0) {
            const bf16_t* a = PJ + (size_t)(r0 - 2) * NAB; const bf16_t* c = PJ + (size_t)(r0 - 1) * NAB;
            z2 = bf2f(a[2560 + ch]) * bf2f(a[3072 + ch]); z1 = bf2f(c[2560 + ch]) * bf2f(c[3072 + ch]);
        }
#pragma unroll 1
        for (int t0 = 0; t0 < 64; t0 += 16) {
            bf16_t rb[16], rc[16], ru[16];
#pragma unroll
            for (int t = 0; t < 16; ++t) { const bf16_t* r = PJ + (size_t)(r0 + t0 + t) * NAB; rb[t] = r[2048 + ch]; rc[t] = r[2560 + ch]; ru[t] = r[3072 + ch]; }
#pragma unroll
            for (int t = 0; t < 16; ++t) {
                const float z0 = bf2f(rc[t]) * bf2f(ru[t]);
                const float y = bf2f(rb[t]) * (cb + w0 * z2 + w1 * z1 + w2 * z0);
                Y[(size_t)(r0 + t0 + t) * D_ + 512 + ch] = f2bf(y);
                z2 = z1; z1 = z0;
            }
        }
    }
}
__device__ __forceinline__ void phase_scan(float* ST, const float* DEC, int per_channel) {
    for (int gid = blockIdx.x * 512 + ltid(); gid < 8 * 16384; gid += gridDim.x * 512) {
        const int bh = gid >> 14, dv = gid & 16383, d = dv & 127;
        float tv[32], dc[32];
#pragma unroll
        for (int p = 0; p < 32; ++p) { const int w = bh * 32 + p; tv[p] = ST[(size_t)w * 16384 + dv]; dc[p] = per_channel ? DEC[w * 128 + d] : DEC[w]; }
        float S = 0.f;
#pragma unroll
        for (int p = 0; p < 32; ++p) { const int w = bh * 32 + p; ST[(size_t)w * 16384 + dv] = S; S = dc[p] * S + tv[p]; }
    }
}
__device__ __forceinline__ void phase_scan_n(float* NS, const float* DSEG) {
    for (int gid = blockIdx.x * 512 + ltid(); gid < 8 * 128; gid += gridDim.x * 512) {
        const int bh = gid >> 7, d = gid & 127;
        float tv[32], dc[32];
#pragma unroll
        for (int p = 0; p < 32; ++p) { const int w = bh * 32 + p; tv[p] = NS[w * 128 + d]; dc[p] = DSEG[w]; }
        float S = 0.f;
#pragma unroll
        for (int p = 0; p < 32; ++p) { const int w = bh * 32 + p; NS[w * 128 + d] = S; S = dc[p] * S + tv[p]; }
    }
}
__device__ __forceinline__ void phase_moba_pre(const Params& P, float* L) {
    bf16_t* PJ = (bf16_t*)(P.ws + OFF_HP); float* KM = (float*)(P.ws + OFF_KMEAN);
    const int tid = ltid();
    const float qscale = 0.08838834764831845f;
    for (int w = blockIdx.x; w < 256; w += gridDim.x) {
        const int b = w >> 7, n = (w >> 2) & 31, h = w & 3;
        const int row0 = b * SEQ_ + n * 256;
        __syncthreads();
        {
            float q1[8], q2[8], k1[8], k2[8];
#pragma unroll
            for (int u = 0; u < 8; ++u) {
                const int e = tid + 512 * u, t = e >> 4, i = e & 15;
                const bf16_t* qp = PJ + (size_t)(row0 + t) * NCD + 2048 + h * 128 + i;
                const bf16_t* kp = PJ + (size_t)(row0 + t) * NCD + 2560 + h * 128 + i;
                q1[u] = bf2f(qp[0]); q2[u] = bf2f(qp[16]); k1[u] = bf2f(kp[0]); k2[u] = bf2f(kp[16]);
            }
#pragma unroll
            for (int u = 0; u < 8; ++u) {
                const int e = tid + 512 * u, t = e >> 4, i = e & 15;
                const int pos = n * 256 + t;
                const float invf = exp2f(-(float)i * (18.931568569324174f / 16.0f));
                const float ang = (float)pos * invf;
                double rev = (double)ang * 0.15915494309189535; rev -= rint(rev);
                const float sn = __builtin_amdgcn_sinf((float)rev), cs = __builtin_amdgcn_cosf((float)rev);
                bf16_t* qp = PJ + (size_t)(row0 + t) * NCD + 2048 + h * 128 + i;
                bf16_t* kp = PJ + (size_t)(row0 + t) * NCD + 2560 + h * 128 + i;
                qp[0] = f2bf(q1[u] * cs - q2[u] * sn); qp[16] = f2bf(q2[u] * cs + q1[u] * sn);
                kp[0] = f2bf(k1[u] * cs - k2[u] * sn); kp[16] = f2bf(k2[u] * cs + k1[u] * sn);
            }
        }
        __syncthreads();
        {
            const int col = tid & 127, tq = tid >> 7;
            float s = 0.f;
            for (int t = 0; t < 64; ++t) s += bf2f(PJ[(size_t)(row0 + tq * 64 + t) * NCD + 2560 + h * 128 + col]);
            L[tq * 128 + col] = s;
        }
        __syncthreads();
        if (tid < 128) KM[(size_t)((b * 4 + h) * 32 + n) * 128 + tid] = ((L[tid] + L[128 + tid]) + (L[256 + tid] + L[384 + tid])) * (1.0f / 256.0f);
        {
            bf16_t* VT = (bf16_t*)(P.ws + OFF_W1T);
            unsigned char* T = (unsigned char*)L + 4096;
#pragma unroll 2
            for (int i = 0; i < 8; ++i) { const int c = tid + 512 * i, r = c >> 4, c16 = c & 15;
                *(u32x4*)(T + r * 272 + c16 * 16) = *(const u32x4*)(PJ + (size_t)(row0 + r) * NCD + 3072 + h * 128 + c16 * 8); }
            __syncthreads();
#pragma unroll 2
            for (int i = 0; i < 8; ++i) { const int c = tid + 512 * i, vcol = c & 127, t8 = c >> 7;
                const unsigned char* tp = T + (t8 * 8) * 272 + vcol * 2;
                u32x4 wv;
                wv.x = (unsigned)*(const bf16_t*)(tp) | ((unsigned)*(const bf16_t*)(tp + 272) << 16);
                wv.y = (unsigned)*(const bf16_t*)(tp + 2 * 272) | ((unsigned)*(const bf16_t*)(tp + 3 * 272) << 16);
                wv.z = (unsigned)*(const bf16_t*)(tp + 4 * 272) | ((unsigned)*(const bf16_t*)(tp + 5 * 272) << 16);
                wv.w = (unsigned)*(const bf16_t*)(tp + 6 * 272) | ((unsigned)*(const bf16_t*)(tp + 7 * 272) << 16);
                *(u32x4*)(VT + (size_t)((b * 4 + h) * 128 + vcol) * SEQ_ + n * 256 + t8 * 8) = wv; }
        }
    }
}
constexpr int MB_S = 272;
constexpr int MB_BUF = 2 * 128 * MB_S;
constexpr int MB_OFF_K = 0, MB_OFF_VT = 128 * MB_S, MB_OFF_KM = MB_BUF, MB_OFF_P = MB_BUF + 16384, MB_OFF_SM = 2 * MB_BUF;
constexpr int LDS_MISC_OFF = 2 * MB_BUF + 512;
constexpr int LDS_TOTAL = LDS_MISC_OFF + 64;
__device__ __forceinline__ void phase_moba_attn_mfma(const Params& P, unsigned char* smem) {
    const bf16_t* PJ = (const bf16_t*)(P.ws + OFF_HP); bf16_t* Y = (bf16_t*)(P.ws + OFF_Y); const float* KM = (const float*)(P.ws + OFF_KMEAN);
    const bf16_t* VT = (const bf16_t*)(P.ws + OFF_W1T);
    const int tid = ltid(), wave = tid >> 6, lane = tid & 63, li = lane & 15, quad = lane >> 4;
    unsigned char* Kl = smem + MB_OFF_K; unsigned char* VTl = smem + MB_OFF_VT; unsigned char* Pw = smem + MB_OFF_P + wave * 16 * MB_S;
    float* KMl = (float*)(smem + MB_OFF_KM); float* SC = (float*)(smem + MB_OFF_P); unsigned* SM = (unsigned*)(smem + MB_OFF_SM);
    const float NEG_INF = -__builtin_inff();
    const float MB_C = 0.08838834764831845f * 1.4426950408889634f;
    for (int w = blockIdx.x; w < 256; w += gridDim.x) {
#pragma unroll 1
        for (int half = 0; half < 2; ++half) {
            const int bh = w & 7, ii = w >> 3, qt = half ? 63 - ii : ii;
            const int b = bh >> 2, h = bh & 3, own = qt >> 1, q0 = qt * 128;
            const size_t rowbase = (size_t)b * SEQ_;
            __syncthreads();
#pragma unroll
            for (int i = 0; i < 4; ++i) { const int c = tid + 512 * i, r = c >> 4, c16 = c & 15;
                *(u32x4*)(Kl + r * MB_S + c16 * 16) = *(const u32x4*)(PJ + (rowbase + q0 + r) * NCD + 2048 + h * 128 + c16 * 8); }
#pragma unroll
            for (int i = 0; i < 2; ++i) { const int c = tid + 512 * i; ((u32x4*)KMl)[c] = ((const u32x4*)(KM + (size_t)(bh * 32) * 128))[c]; }
            __syncthreads();
            {
                const int q = tid & 127, g = tid >> 7;
                float s8[8];
#pragma unroll
                for (int nn = 0; nn < 8; ++nn) s8[nn] = 0.f;
#pragma unroll 2
                for (int d8 = 0; d8 < 16; ++d8) {
                    const u32x4 qw = *(const u32x4*)(Kl + q * MB_S + d8 * 16);
                    const float q0f = __uint_as_float(qw.x << 16), q1f = __uint_as_float(qw.x & 0xFFFF0000u), q2f = __uint_as_float(qw.y << 16), q3f = __uint_as_float(qw.y & 0xFFFF0000u);
                    const float q4f = __uint_as_float(qw.z << 16), q5f = __uint_as_float(qw.z & 0xFFFF0000u), q6f = __uint_as_float(qw.w << 16), q7f = __uint_as_float(qw.w & 0xFFFF0000u);
#pragma unroll
                    for (int nn = 0; nn < 8; ++nn) {
                        const float* km = KMl + (g * 8 + nn) * 128 + d8 * 8;
                        const f32x4 k0 = *(const f32x4*)km, k1 = *(const f32x4*)(km + 4);
                        s8[nn] += (q0f * k0[0] + q1f * k0[1]) + (q2f * k0[2] + q3f * k0[3]) + (q4f * k1[0] + q5f * k1[1]) + (q6f * k1[2] + q7f * k1[3]);
                    }
                }
#pragma unroll
                for (int nn = 0; nn < 8; ++nn) { const int n = g * 8 + nn; SC[q * 33 + n] = (n < own) ? s8[nn] : NEG_INF; }
            }
            __syncthreads();
            if (tid < 128) {
                unsigned mask = 1u << own;
                float sc[32];
#pragma unroll
                for (int n = 0; n < 32; ++n) sc[n] = SC[tid * 33 + n];
#pragma unroll
                for (int r = 0; r < 3; ++r) {
                    float best = NEG_INF; int bi = -1;
#pragma unroll
                    for (int n = 0; n < 32; ++n) { const bool gt = sc[n] > best; best = gt ? sc[n] : best; bi = gt ? n : bi; }
                    if (bi >= 0) mask |= 1u << bi;
#pragma unroll
                    for (int n = 0; n < 32; ++n) sc[n] = (n == bi) ? NEG_INF : sc[n];
                }
                SM[tid] = mask;
            }
            __syncthreads();
            bf16x8 qf[4];
#pragma unroll
            for (int kc = 0; kc < 4; ++kc) qf[kc] = *(const bf16x8*)(Kl + (wave * 16 + li) * MB_S + (kc * 32 + quad * 8) * 2);
            const unsigned smq = SM[wave * 16 + li];
            unsigned wum = smq;
            wum |= __shfl_xor(wum, 1); wum |= __shfl_xor(wum, 2); wum |= __shfl_xor(wum, 4); wum |= __shfl_xor(wum, 8);
            unsigned um = SM[lane] | SM[64 + lane];
#pragma unroll
            for (int o = 32; o >= 1; o >>= 1) um |= __shfl_xor(um, o);
            um = __builtin_amdgcn_readfirstlane(um); wum = __builtin_amdgcn_readfirstlane(wum);
            const int qpos = q0 + wave * 16 + li;
            float m = NEG_INF, l = 0.f; f32x4 O[8];
#pragma unroll
            for (int vt = 0; vt < 8; ++vt) O[vt] = (f32x4){0.f, 0.f, 0.f, 0.f};
            const int nsteps = 2 * (own + 1);
#define MB_VALID(s_) ((((um >> (own - ((s_) >> 1))) & 1u) != 0u) && !((((s_) >> 1) == 0) && ((own * 256 + ((s_) & 1) * 128) > q0 + 127)))
            int step = 0;
            while (step < nsteps && !MB_VALID(step)) ++step;
            int nstep = step + 1;
            while (nstep < nsteps && !MB_VALID(nstep)) ++nstep;
            u32x4 kreg[4], vreg[4];
            const int sr = tid >> 4, sc16 = tid & 15;
#define MB_GLOAD(s_) do { const int k0_ = (own - ((s_) >> 1)) * 256 + ((s_) & 1) * 128; _Pragma("unroll") for (int i = 0; i < 4; ++i) { \
                kreg[i] = *(const u32x4*)(PJ + (rowbase + k0_ + sr + 32 * i) * NCD + 2560 + h * 128 + sc16 * 8); \
                vreg[i] = *(const u32x4*)(VT + (size_t)(bh * 128 + sr + 32 * i) * SEQ_ + k0_ + sc16 * 8); } } while (0)
            const int vperm_lo = (sc16 >> 2) * 64 + (((sc16 & 3) < 2) ? 4 * (sc16 & 3) : 4 * ((sc16 & 3) - 2) + 1) * 8;
#define MB_LWRITE(buf_) do { _Pragma("unroll") for (int i = 0; i < 4; ++i) { *(u32x4*)(smem + (buf_) * MB_BUF + MB_OFF_K + (sr + 32 * i) * MB_S + sc16 * 16) = kreg[i]; \
                unsigned char* vrow_ = smem + (buf_) * MB_BUF + MB_OFF_VT + (sr + 32 * i) * MB_S + vperm_lo; u32x2 lo_, hi_; lo_.x = vreg[i].x; lo_.y = vreg[i].y; hi_.x = vreg[i].z; hi_.y = vreg[i].w; \
                *(u32x2*)vrow_ = lo_; *(u32x2*)(vrow_ + 16) = hi_; } } while (0)
            if (step < nsteps) MB_GLOAD(step);
            lds_barrier();
            if (step < nsteps) { MB_LWRITE(0); if (nstep < nsteps) MB_GLOAD(nstep); }
            int bufi = 0;
#pragma unroll 1
            while (step < nsteps) {
                const int n = own - (step >> 1), key0 = n * 256 + (step & 1) * 128;
                unsigned char* Kl = smem + bufi * MB_BUF + MB_OFF_K; unsigned char* VTl = smem + bufi * MB_BUF + MB_OFF_VT;
                lds_barrier();
                int nnstep = nstep + 1;
                while (nnstep < nsteps && !MB_VALID(nnstep)) ++nnstep;
                if (nstep < nsteps) { MB_LWRITE(bufi ^ 1); if (nnstep < nsteps) MB_GLOAD(nnstep); }
                if ((wum >> n) & 1u) {
                    f32x4 S[8];
                    {
                        bf16x8 kf[2][4];
#define MB_LDK(slot, st_) do { _Pragma("unroll") for (int kc = 0; kc < 4; ++kc) kf[slot][kc] = *(const bf16x8*)(Kl + ((st_) * 16 + li) * MB_S + (kc * 32 + quad * 8) * 2); } while (0)
                        MB_LDK(0, 0);
#pragma unroll
                        for (int st = 0; st < 8; ++st) {
                            if (st + 1 < 8) MB_LDK((st + 1) & 1, st + 1);
                            __builtin_amdgcn_sched_barrier(0);
                            f32x4 acc = (f32x4){0.f, 0.f, 0.f, 0.f};
#pragma unroll
                            for (int kc = 0; kc < 4; ++kc) acc = __builtin_amdgcn_mfma_f32_16x16x32_bf16(kf[st & 1][kc], qf[kc], acc, 0, 0, 0);
                            S[st] = acc;
                            __builtin_amdgcn_sched_barrier(0);
                        }
#undef MB_LDK
                    }
                    const bool sel = (smq >> n) & 1u;
                    float mj = NEG_INF;
                    if (n == own) {
#pragma unroll
                        for (int st = 0; st < 8; ++st)
#pragma unroll
                            for (int j = 0; j < 4; ++j) { const int kpos = key0 + st * 16 + quad * 4 + j; const float sv = (kpos <= qpos) ? S[st][j] : NEG_INF; S[st][j] = sv; mj = fmaxf(mj, sv); }
                    } else {
#pragma unroll
                        for (int st = 0; st < 8; ++st) mj = fmaxf(fmaxf(mj, fmaxf(S[st][0], S[st][1])), fmaxf(S[st][2], S[st][3]));
                        mj = sel ? mj : NEG_INF;
                    }
                    mj = fmaxf(mj, __shfl_xor(mj, 16)); mj = fmaxf(mj, __shfl_xor(mj, 32));
                    const float mn = fmaxf(m, mj), msafe = (mn == NEG_INF) ? 0.f : mn;
                    const float alpha = __builtin_amdgcn_exp2f((m - msafe) * MB_C);
                    const float mc = sel ? msafe * MB_C : __builtin_inff();
                    float ls = 0.f;
#pragma unroll
                    for (int st = 0; st < 8; ++st)
#pragma unroll
                        for (int j = 0; j < 4; ++j) { const float pe = __builtin_amdgcn_exp2f(fmaf(S[st][j], MB_C, -mc)); S[st][j] = pe; ls += pe; }
                    ls += __shfl_xor(ls, 16); ls += __shfl_xor(ls, 32);
                    l = l * alpha + ls; m = mn;
                    if (__builtin_amdgcn_ballot_w64(alpha != 1.0f) != 0ull) {
#pragma unroll
                        for (int vt = 0; vt < 8; ++vt) O[vt] *= alpha;
                    }
                    {
                        bf16x8 pf[4];
#pragma unroll
                        for (int c = 0; c < 4; ++c) { u32x4 pw; pw.x = cvt_pk_bf16(S[2 * c][0], S[2 * c][1]); pw.y = cvt_pk_bf16(S[2 * c][2], S[2 * c][3]); pw.z = cvt_pk_bf16(S[2 * c + 1][0], S[2 * c + 1][1]); pw.w = cvt_pk_bf16(S[2 * c + 1][2], S[2 * c + 1][3]); pf[c] = __builtin_bit_cast(bf16x8, pw); }
                        u32x4 vfr[4];
#define MB_LDV(slot, g_) do { vfr[slot] = *(const u32x4*)(VTl + ((((g_) & 7) * 16) + li) * MB_S + ((g_) >> 3) * 64 + quad * 16); } while (0)
                        MB_LDV(0, 0); MB_LDV(1, 1); MB_LDV(2, 2);
#pragma unroll
                        for (int g = 0; g < 32; ++g) {
                            if (g + 3 < 32) MB_LDV((g + 3) & 3, g + 3);
                            __builtin_amdgcn_sched_barrier(0);
                            O[g & 7] = __builtin_amdgcn_mfma_f32_16x16x32_bf16(__builtin_bit_cast(bf16x8, vfr[g & 3]), pf[g >> 3], O[g & 7], 0, 0, 0);
                            __builtin_amdgcn_sched_barrier(0);
                        }
#undef MB_LDV
                    }
                }
                step = nstep; nstep = nnstep; bufi ^= 1;
            }
#undef MB_GLOAD
#undef MB_LWRITE
#undef MB_VALID
            {
                const float inv = 1.0f / l;
                bf16_t* yp = Y + (rowbase + qpos) * D_ + 512 + h * 128 + quad * 4;
#pragma unroll
                for (int vt = 0; vt < 8; ++vt) { u32x2 w2; w2.x = cvt_pk_bf16(O[vt][0] * inv, O[vt][1] * inv); w2.y = cvt_pk_bf16(O[vt][2] * inv, O[vt][3] * inv); *(u32x2*)(yp + vt * 16) = w2; }
            }
        }
    }
}

constexpr int ML_OFF_K = 0, ML_OFF_VT = 128 * MB_S, ML_OFF_Q = 2 * 128 * MB_S, ML_OFF_TAB = 3 * 128 * MB_S;
__device__ __forceinline__ void phase_mlstm_A2(const Params& P, unsigned char* smem) {
    unsigned char* ws = P.ws;
    const bf16_t* PJ = (const bf16_t*)(ws + OFF_HP); const float* GATES = (const float*)(ws + OFF_GATES);
    float* NUML = (float*)(ws + OFF_OLOC); float* DENL = (float*)(ws + OFF_DENL); float* CUMF = (float*)(ws + OFF_CUMF);
    float* ST = (float*)(ws + OFF_ST); float* NS = (float*)(ws + OFF_NS); float* DSEG = (float*)(ws + OFF_DSEG);
    const int tid = ltid(), wave = tid >> 6, lane = tid & 63, li = lane & 15, quad = lane >> 4;
    unsigned char* Kl = smem + ML_OFF_K; unsigned char* VTl = smem + ML_OFF_VT; unsigned char* Ql = smem + ML_OFF_Q;
    float* Bq = (float*)(smem + ML_OFF_TAB); float* Gk = Bq + 256; float* We = Bq + 512; float* NR = Bq + 768;
    const float qscale = 0.08838834764831845f;
    const int sr = tid >> 4, sc16 = tid & 15;
    const int tr = tid & 31, tc16 = tid >> 5;
    for (int w = blockIdx.x; w < 256; w += gridDim.x) {
        const int b = w >> 7, h = (w >> 5) & 3, p = w & 31;
        const size_t row0 = (size_t)b * SEQ_ + p * 256;
        __syncthreads();
        if (tid < 64) {
            const float bi = P.gate_bias[h], bfg = P.gate_bias[4 + h];
            float lf[4], lg[4];
#pragma unroll
            for (int e = 0; e < 4; ++e) { const float* gp = GATES + (row0 + 4 * lane + e) * 8; lg[e] = gp[h] + bi; const float z = gp[4 + h] + bfg; lf[e] = (z >= 0.f) ? -log1pf(__expf(-z)) : (z - log1pf(__expf(z))); }
            const float c0 = lf[0], c1 = c0 + lf[1], c2 = c1 + lf[2], c3 = c2 + lf[3];
            float inc = c3;
#pragma unroll
            for (int o = 1; o < 64; o <<= 1) { const float up = __shfl_up(inc, o); if (lane >= o) inc += up; }
            const float pre = inc - c3, btot = __shfl(inc, 63);
            const float bb[4] = {pre + c0, pre + c1, pre + c2, pre + c3};
#pragma unroll
            for (int e = 0; e < 4; ++e) { const int t = 4 * lane + e; Bq[t] = bb[e]; Gk[t] = lg[e] - bb[e]; We[t] = __expf(btot - bb[e] + lg[e]); CUMF[(row0 + t) * 4 + h] = __expf(bb[e]); }
            if (lane == 63) DSEG[w] = __expf(btot);
        }
        f32x4 SC[8];
#pragma unroll
        for (int vt = 0; vt < 8; ++vt) SC[vt] = (f32x4){0.f, 0.f, 0.f, 0.f};
        float nacc = 0.f;
        bf16x8 qf[4]; f32x4 O[8]; float dtot = 0.f;
#pragma unroll
        for (int vt = 0; vt < 8; ++vt) O[vt] = (f32x4){0.f, 0.f, 0.f, 0.f};
#pragma unroll
        for (int kc = 0; kc < 4; ++kc) qf[kc] = (bf16x8){0, 0, 0, 0, 0, 0, 0, 0};
#pragma unroll 1
        for (int kt = 0; kt < 2; ++kt) {
            __syncthreads();
#pragma unroll
            for (int i = 0; i < 4; ++i) {
                *(u32x4*)(Kl + (sr + 32 * i) * MB_S + sc16 * 16) = *(const u32x4*)(PJ + (row0 + kt * 128 + sr + 32 * i) * NCD + 512 + h * 128 + sc16 * 8);
                const u32x4 vv = *(const u32x4*)(PJ + (row0 + kt * 128 + tr + 32 * i) * NCD + 1024 + h * 128 + tc16 * 8);
                unsigned char* vp = VTl + (tc16 * 8) * MB_S + (tr + 32 * i) * 2;
                *(bf16_t*)(vp) = (bf16_t)(vv.x & 0xFFFFu); *(bf16_t*)(vp + MB_S) = (bf16_t)(vv.x >> 16);
                *(bf16_t*)(vp + 2 * MB_S) = (bf16_t)(vv.y & 0xFFFFu); *(bf16_t*)(vp + 3 * MB_S) = (bf16_t)(vv.y >> 16);
                *(bf16_t*)(vp + 4 * MB_S) = (bf16_t)(vv.z & 0xFFFFu); *(bf16_t*)(vp + 5 * MB_S) = (bf16_t)(vv.z >> 16);
                *(bf16_t*)(vp + 6 * MB_S) = (bf16_t)(vv.w & 0xFFFFu); *(bf16_t*)(vp + 7 * MB_S) = (bf16_t)(vv.w >> 16);
            }
#pragma unroll 1
            for (int qt = kt; qt < 2; ++qt) {
                __syncthreads();
                if (kt == 0) {
#pragma unroll
                    for (int i = 0; i < 4; ++i) *(u32x4*)(Ql + (sr + 32 * i) * MB_S + sc16 * 16) = *(const u32x4*)(PJ + (row0 + qt * 128 + sr + 32 * i) * NCD + h * 128 + sc16 * 8);
                    __syncthreads();
#pragma unroll
                    for (int kc = 0; kc < 4; ++kc) qf[kc] = *(const bf16x8*)(Ql + (wave * 16 + li) * MB_S + (kc * 32 + quad * 8) * 2);
#pragma unroll
                    for (int vt = 0; vt < 8; ++vt) O[vt] = (f32x4){0.f, 0.f, 0.f, 0.f};
                    dtot = 0.f;
                }
                const int qtok = qt * 128 + wave * 16 + li;
                const float bq = Bq[qtok];
                const bool diag = (qt == kt);
                f32x4 S[8];
#pragma unroll
                for (int st = 0; st < 8; ++st) {
                    f32x4 acc = (f32x4){0.f, 0.f, 0.f, 0.f};
#pragma unroll
                    for (int kc = 0; kc < 4; ++kc) {
                        const bf16x8 kf = *(const bf16x8*)(Kl + (st * 16 + li) * MB_S + (kc * 32 + quad * 8) * 2);
                        acc = __builtin_amdgcn_mfma_f32_16x16x32_bf16(kf, qf[kc], acc, 0, 0, 0);
                    }
                    S[st] = acc;
                }
                __builtin_amdgcn_sched_barrier(0);
                float dsum = 0.f;
#pragma unroll
                for (int st = 0; st < 8; ++st) {
                    const f32x4 g4 = *(const f32x4*)(Gk + kt * 128 + st * 16 + quad * 4);
#pragma unroll
                    for (int j = 0; j < 4; ++j) {
                        const int ktok = kt * 128 + st * 16 + quad * 4 + j;
                        const float pe = (!diag || ktok <= qtok) ? S[st][j] * (qscale * __expf(bq + g4[j])) : 0.f;
                        S[st][j] = pe; dsum += pe;
                    }
                }
                dsum += __shfl_xor(dsum, 16); dsum += __shfl_xor(dsum, 32);
                dtot += dsum;
                __builtin_amdgcn_sched_barrier(0);
#pragma unroll
                for (int c = 0; c < 4; ++c) {
                    u32x4 pw; pw.x = cvt_pk_bf16(S[2 * c][0], S[2 * c][1]); pw.y = cvt_pk_bf16(S[2 * c][2], S[2 * c][3]); pw.z = cvt_pk_bf16(S[2 * c + 1][0], S[2 * c + 1][1]); pw.w = cvt_pk_bf16(S[2 * c + 1][2], S[2 * c + 1][3]);
                    const bf16x8 pf = __builtin_bit_cast(bf16x8, pw);
#pragma unroll
                    for (int vt = 0; vt < 8; ++vt) {
                        const unsigned char* vp = VTl + (vt * 16 + li) * MB_S + (c * 32 + quad * 4) * 2;
                        const u32x2 lo = *(const u32x2*)vp, hi = *(const u32x2*)(vp + 32);
                        u32x4 vw; vw.x = lo.x; vw.y = lo.y; vw.z = hi.x; vw.w = hi.y;
                        O[vt] = __builtin_amdgcn_mfma_f32_16x16x32_bf16(__builtin_bit_cast(bf16x8, vw), pf, O[vt], 0, 0, 0);
                    }
                }
                __builtin_amdgcn_sched_barrier(0);
                if (qt == kt) {
                    float* np_ = NUML + (row0 + qtok) * 512 + h * 128 + quad * 4;
#pragma unroll
                    for (int vt = 0; vt < 8; ++vt) *(f32x4*)(np_ + vt * 16) = O[vt];
                    if (quad == 0) DENL[(row0 + qtok) * 4 + h] = dtot;
                }
            }
            __builtin_amdgcn_sched_barrier(0);
#pragma unroll 1
            for (int kc = 0; kc < 4; ++kc) {
                const f32x4 w0 = *(const f32x4*)(We + kt * 128 + kc * 32 + quad * 8), w1 = *(const f32x4*)(We + kt * 128 + kc * 32 + quad * 8 + 4);
                const unsigned char* kp = Kl + (kc * 32 + quad * 8) * MB_S + (wave * 16 + li) * 2;
                u32x4 kw;
                kw.x = cvt_pk_bf16(bf2f(*(const bf16_t*)(kp)) * w0[0], bf2f(*(const bf16_t*)(kp + MB_S)) * w0[1]);
                kw.y = cvt_pk_bf16(bf2f(*(const bf16_t*)(kp + 2 * MB_S)) * w0[2], bf2f(*(const bf16_t*)(kp + 3 * MB_S)) * w0[3]);
                kw.z = cvt_pk_bf16(bf2f(*(const bf16_t*)(kp + 4 * MB_S)) * w1[0], bf2f(*(const bf16_t*)(kp + 5 * MB_S)) * w1[1]);
                kw.w = cvt_pk_bf16(bf2f(*(const bf16_t*)(kp + 6 * MB_S)) * w1[2], bf2f(*(const bf16_t*)(kp + 7 * MB_S)) * w1[3]);
                const bf16x8 kfr = __builtin_bit_cast(bf16x8, kw);
#pragma unroll
                for (int vt = 0; vt < 8; ++vt) {
                    const bf16x8 vf = *(const bf16x8*)(VTl + (vt * 16 + li) * MB_S + (kc * 32 + quad * 8) * 2);
                    SC[vt] = __builtin_amdgcn_mfma_f32_16x16x32_bf16(vf, kfr, SC[vt], 0, 0, 0);
                }
            }
            {
                const int d = tid & 127, g = tid >> 7;
#pragma unroll 4
                for (int t = 0; t < 32; ++t) nacc += We[kt * 128 + g * 32 + t] * bf2f(*(const bf16_t*)(Kl + (g * 32 + t) * MB_S + d * 2));
            }
        }
#pragma unroll
        for (int vt = 0; vt < 8; ++vt)
#pragma unroll
            for (int j = 0; j < 4; ++j) ST[(size_t)w * 16384 + (vt * 16 + quad * 4 + j) * 128 + wave * 16 + li] = SC[vt][j];
        NR[(tid >> 7) * 128 + (tid & 127)] = nacc;
        __syncthreads();
        if (tid < 128) NS[w * 128 + tid] = (NR[tid] + NR[128 + tid]) + (NR[256 + tid] + NR[384 + tid]);
    }
}
template <bool HG> __device__ __forceinline__ float gatef_(float g) { const float s = sigmoidf_(g); return HG ? g * s : s; }
template <bool HG> __device__ __forceinline__ void phase_lin_C2(const Params& P, unsigned char* smem) {
    unsigned char* ws = P.ws;
    const bf16_t* __restrict__ PJ = (const bf16_t*)(ws + OFF_HP); bf16_t* __restrict__ Y = (bf16_t*)(ws + OFF_Y);
    const float* __restrict__ NUML = (const float*)(ws + OFF_OLOC); const float* __restrict__ DENL = (const float*)(ws + OFF_DENL); const float* __restrict__ CUMF = (const float*)(ws + OFF_CUMF);
    const float* __restrict__ ST = (const float*)(ws + OFF_ST); const float* __restrict__ NS = (const float*)(ws + OFF_NS);
    const int tid = ltid(), wave = tid >> 6, lane = tid & 63, li = lane & 15, quad = lane >> 4;
    unsigned char* CTl = smem; unsigned char* Ql = smem + 128 * MB_S; float* NP = (float*)(smem + 2 * 128 * MB_S);
    const float qscale = 0.08838834764831845f;
    const int sr = tid >> 4, sc16 = tid & 15;
    constexpr int LDP = HG ? NAB : NCD;
    const float* gain_ = HG ? P.hg_norm : P.ml_norm;
    for (int w = blockIdx.x; w < 256; w += gridDim.x) {
        const int b = w >> 7, h = (w >> 5) & 3, p = w & 31;
        const size_t row0 = (size_t)b * SEQ_ + p * 256;
        __syncthreads();
#pragma unroll
        for (int i = 0; i < 4; ++i) {
            const float* sp = ST + (size_t)w * 16384 + (sr + 32 * i) * 128 + sc16 * 8;
            const f32x4 a = *(const f32x4*)sp, c = *(const f32x4*)(sp + 4);
            u32x4 pw; pw.x = cvt_pk_bf16(a[0], a[1]); pw.y = cvt_pk_bf16(a[2], a[3]); pw.z = cvt_pk_bf16(c[0], c[1]); pw.w = cvt_pk_bf16(c[2], c[3]);
            *(u32x4*)(CTl + (sr + 32 * i) * MB_S + sc16 * 16) = pw;
        }
        if (!HG) { if (tid < 128) NP[tid] = NS[w * 128 + tid]; }
#pragma unroll 1
        for (int qt = 0; qt < 2; ++qt) {
            __syncthreads();
#pragma unroll
            for (int i = 0; i < 4; ++i) *(u32x4*)(Ql + (sr + 32 * i) * MB_S + sc16 * 16) = *(const u32x4*)(PJ + (row0 + qt * 128 + sr + 32 * i) * LDP + h * 128 + sc16 * 8);
            const size_t row = row0 + qt * 128 + wave * 16 + li;
            f32x4 nlv[8]; u32x2 gwv[8]; float cf_raw = 1.0f, den_raw = 0.f;
#pragma unroll
            for (int vt = 0; vt < 8; ++vt) { nlv[vt] = *(const f32x4*)(NUML + row * 512 + h * 128 + vt * 16 + quad * 4); gwv[vt] = *(const u32x2*)(PJ + row * LDP + 1536 + h * 128 + vt * 16 + quad * 4); }
            if (!HG) { cf_raw = CUMF[row * 4 + h]; den_raw = DENL[row * 4 + h]; }
            __syncthreads();
            bf16x8 qf[4];
#pragma unroll
            for (int kc = 0; kc < 4; ++kc) qf[kc] = *(const bf16x8*)(Ql + (wave * 16 + li) * MB_S + (kc * 32 + quad * 8) * 2);
            f32x4 O[8];
#pragma unroll
            for (int vt = 0; vt < 8; ++vt) {
                f32x4 acc = (f32x4){0.f, 0.f, 0.f, 0.f};
#pragma unroll
                for (int kc = 0; kc < 4; ++kc) {
                    const bf16x8 cf_ = *(const bf16x8*)(CTl + (vt * 16 + li) * MB_S + (kc * 32 + quad * 8) * 2);
                    acc = __builtin_amdgcn_mfma_f32_16x16x32_bf16(cf_, qf[kc], acc, 0, 0, 0);
                }
                O[vt] = acc;
            }
            float dc = 0.f;
            if (!HG) {
#pragma unroll
            for (int e = 0; e < 4; ++e) {
                const u32x4 qw = *(const u32x4*)(Ql + (wave * 16 + li) * MB_S + (quad * 32 + e * 8) * 2);
                const float* np_ = NP + quad * 32 + e * 8;
                dc += __uint_as_float(qw.x << 16) * np_[0] + __uint_as_float(qw.x & 0xFFFF0000u) * np_[1] + __uint_as_float(qw.y << 16) * np_[2] + __uint_as_float(qw.y & 0xFFFF0000u) * np_[3]
                    + __uint_as_float(qw.z << 16) * np_[4] + __uint_as_float(qw.z & 0xFFFF0000u) * np_[5] + __uint_as_float(qw.w << 16) * np_[6] + __uint_as_float(qw.w & 0xFFFF0000u) * np_[7];
            }
            dc += __shfl_xor(dc, 16); dc += __shfl_xor(dc, 32);
            }
            float cfq = 1.0f, invd = 1.0f;
            if (!HG) { cfq = cf_raw * qscale; const float den = den_raw + cfq * dc; invd = 1.0f / fmaxf(fabsf(den), 1.0f); }
            float ssq = 0.f;
#pragma unroll
            for (int vt = 0; vt < 8; ++vt) {
                const f32x4 nl = nlv[vt];
                const f32x4 hv = (nl + O[vt] * cfq) * invd;
                O[vt] = hv; ssq += (hv[0] * hv[0] + hv[1] * hv[1]) + (hv[2] * hv[2] + hv[3] * hv[3]);
            }
            ssq += __shfl_xor(ssq, 16); ssq += __shfl_xor(ssq, 32);
            const float rs = rsqrtf(ssq * (1.0f / 128.0f) + EPS_);
#pragma unroll
            for (int vt = 0; vt < 8; ++vt) {
                const int col = h * 128 + vt * 16 + quad * 4;
                const u32x2 gw = gwv[vt];
                const f32x4 gn = *(const f32x4*)(gain_ + col);
                const float y0 = O[vt][0] * rs * gn[0] * gatef_<HG>(__uint_as_float(gw.x << 16)), y1 = O[vt][1] * rs * gn[1] * gatef_<HG>(__uint_as_float(gw.x & 0xFFFF0000u));
                const float y2 = O[vt][2] * rs * gn[2] * gatef_<HG>(__uint_as_float(gw.y << 16)), y3 = O[vt][3] * rs * gn[3] * gatef_<HG>(__uint_as_float(gw.y & 0xFFFF0000u));
                u32x2 yw; yw.x = cvt_pk_bf16(y0, y1); yw.y = cvt_pk_bf16(y2, y3);
                *(u32x2*)(Y + row * D_ + col) = yw;
            }
        }
    }
}

constexpr int HG_S2 = 80;
constexpr int HG_OFF_Q = 0, HG_OFF_K = 32 * MB_S, HG_OFF_KT = 2 * 32 * MB_S, HG_OFF_VT = HG_OFF_KT + 128 * HG_S2, HG_OFF_SW = HG_OFF_VT + 128 * HG_S2, HG_OFF_TAB = HG_OFF_SW + 8 * 16 * MB_S;
__device__ __forceinline__ void phase_hgrn_A2(const Params& P, unsigned char* smem) {
    unsigned char* ws = P.ws;
    bf16_t* PJ = (bf16_t*)(ws + OFF_HP); const float* LB = (const float*)(ws + OFF_LB);
    float* OLOC = (float*)(ws + OFF_OLOC); float* ST = (float*)(ws + OFF_ST); float* DEC = (float*)(ws + OFF_DEC);
    const int tid = ltid(), wave = tid >> 6, lane = tid & 63, li = lane & 15, quad = lane >> 4;
    unsigned char* Ql = smem + HG_OFF_Q; unsigned char* Kl = smem + HG_OFF_K; unsigned char* KT2 = smem + HG_OFF_KT; unsigned char* VTl = smem + HG_OFF_VT;
    unsigned char* SWw = smem + HG_OFF_SW + wave * 16 * MB_S;
    float* Eend = (float*)(smem + HG_OFF_TAB); float* GT = Eend + 128;
    const int d = tid & 127, tg = tid >> 7;
    const int tr = tid & 31, tc16 = tid >> 5;
    for (int w = blockIdx.x; w < 256; w += gridDim.x) {
        const int b = w >> 7, h = (w >> 5) & 3, p = w & 31;
        const size_t row0 = (size_t)b * SEQ_ + p * 256;
        const float lbv = LB[h * 128 + d];
        float Bstart = 0.f;
        f32x4 SA[8];
#pragma unroll
        for (int dt = 0; dt < 8; ++dt) SA[dt] = (f32x4){0.f, 0.f, 0.f, 0.f};
        __syncthreads();
        for (int i = lane; i < 16 * MB_S / 16; i += 64) ((u32x4*)SWw)[i] = (u32x4){0u, 0u, 0u, 0u};
        asm volatile("s_waitcnt lgkmcnt(0)" ::: "memory");
        bf16_t rq[8], rf[8]; u32x4 rv;
        {
            const bf16_t* base = PJ + (row0 + tg * 8) * NAB + h * 128 + d;
#pragma unroll
            for (int e = 0; e < 8; ++e) { rq[e] = base[(size_t)e * NAB]; rf[e] = base[(size_t)e * NAB + 512]; }
            rv = *(const u32x4*)(PJ + (row0 + tr) * NAB + 1024 + h * 128 + tc16 * 8);
        }
#pragma unroll 1
        for (int c = 0; c < 8; ++c) {
            float qs[8], kk[8], cb[8]; float run = 0.f;
#pragma unroll
            for (int e = 0; e < 8; ++e) {
                const float f = lbv + (1.f - lbv) * sigmoidf_(bf2f(rf[e]));
                run += __logf(f); cb[e] = run; kk[e] = 1.f - f;
                const float q = bf2f(rq[e]); qs[e] = q * sigmoidf_(q);
            }
            lds_barrier();
            GT[tg * 128 + d] = run;
            {
                unsigned char* vp = VTl + (tc16 * 8) * HG_S2 + tr * 2;
                *(bf16_t*)(vp) = (bf16_t)(rv.x & 0xFFFFu); *(bf16_t*)(vp + HG_S2) = (bf16_t)(rv.x >> 16);
                *(bf16_t*)(vp + 2 * HG_S2) = (bf16_t)(rv.y & 0xFFFFu); *(bf16_t*)(vp + 3 * HG_S2) = (bf16_t)(rv.y >> 16);
                *(bf16_t*)(vp + 4 * HG_S2) = (bf16_t)(rv.z & 0xFFFFu); *(bf16_t*)(vp + 5 * HG_S2) = (bf16_t)(rv.z >> 16);
                *(bf16_t*)(vp + 6 * HG_S2) = (bf16_t)(rv.w & 0xFFFFu); *(bf16_t*)(vp + 7 * HG_S2) = (bf16_t)(rv.w >> 16);
            }
            lds_barrier();
            const float g0 = GT[d], g1 = GT[128 + d], g2 = GT[256 + d], g3 = GT[384 + d];
            const float pre = (tg > 0 ? g0 : 0.f) + (tg > 1 ? g1 : 0.f) + (tg > 2 ? g2 : 0.f), bend = (g0 + g1) + (g2 + g3);
            const size_t rsub = row0 + c * 32;
            const float ebend = __expf(bend), ebst = __expf(Bstart);
#pragma unroll
            for (int e = 0; e < 8; ++e) {
                const int t = tg * 8 + e; const float bt = pre + cb[e];
                const float ep = __expf(bt), en = __expf(-bt);
                const float qd = qs[e] * ep, kd = kk[e] * en;
                *(bf16_t*)(Ql + t * MB_S + d * 2) = f2bf(qd);
                *(bf16_t*)(Kl + t * MB_S + d * 2) = f2bf(kd);
                *(bf16_t*)(KT2 + d * HG_S2 + t * 2) = f2bf(kd * ebend);
                PJ[(rsub + t) * NAB + h * 128 + d] = f2bf(qd * ebst);
            }
            if (tg == 0) Eend[d] = ebend;
            Bstart += bend;
            if (c < 7) {
                const bf16_t* base = PJ + (rsub + 32 + tg * 8) * NAB + h * 128 + d;
#pragma unroll
                for (int e = 0; e < 8; ++e) { rq[e] = base[(size_t)e * NAB]; rf[e] = base[(size_t)e * NAB + 512]; }
                rv = *(const u32x4*)(PJ + (rsub + 32 + tr) * NAB + 1024 + h * 128 + tc16 * 8);
            }
            lds_barrier();
            bf16x8 qf[2][4];
#pragma unroll
            for (int qt = 0; qt < 2; ++qt)
#pragma unroll
                for (int kc = 0; kc < 4; ++kc) qf[qt][kc] = *(const bf16x8*)(Ql + (qt * 16 + li) * MB_S + (kc * 32 + quad * 8) * 2);
            f32x4 S00 = (f32x4){0.f, 0.f, 0.f, 0.f}, S01 = S00, S11 = S00;
#pragma unroll
            for (int kc = 0; kc < 4; ++kc) {
                const bf16x8 k0 = *(const bf16x8*)(Kl + li * MB_S + (kc * 32 + quad * 8) * 2), k1 = *(const bf16x8*)(Kl + (16 + li) * MB_S + (kc * 32 + quad * 8) * 2);
                S00 = __builtin_amdgcn_mfma_f32_16x16x32_bf16(k0, qf[0][kc], S00, 0, 0, 0);
                S01 = __builtin_amdgcn_mfma_f32_16x16x32_bf16(k0, qf[1][kc], S01, 0, 0, 0);
                S11 = __builtin_amdgcn_mfma_f32_16x16x32_bf16(k1, qf[1][kc], S11, 0, 0, 0);
            }
#pragma unroll
            for (int j = 0; j < 4; ++j) { const bool ok = (quad * 4 + j) <= li; S00[j] = ok ? S00[j] : 0.f; S11[j] = ok ? S11[j] : 0.f; }
            u32x4 pw0, pw1;
            pw0.x = cvt_pk_bf16(S00[0], S00[1]); pw0.y = cvt_pk_bf16(S00[2], S00[3]); pw0.z = 0u; pw0.w = 0u;
            pw1.x = cvt_pk_bf16(S01[0], S01[1]); pw1.y = cvt_pk_bf16(S01[2], S01[3]); pw1.z = cvt_pk_bf16(S11[0], S11[1]); pw1.w = cvt_pk_bf16(S11[2], S11[3]);
            const unsigned char* vrow = VTl + (wave * 16 + li) * HG_S2;
            u32x4 vwi; { const u32x2 lo = *(const u32x2*)(vrow + quad * 8), hi = *(const u32x2*)(vrow + 32 + quad * 8); vwi.x = lo.x; vwi.y = lo.y; vwi.z = hi.x; vwi.w = hi.y; }
            const bf16x8 vfi = __builtin_bit_cast(bf16x8, vwi);
#pragma unroll
            for (int qt = 0; qt < 2; ++qt) {
                f32x4 O = (f32x4){0.f, 0.f, 0.f, 0.f};
#pragma unroll
                for (int kc = 0; kc < 4; ++kc) {
                    const bf16x8 sf = *(const bf16x8*)(SWw + li * MB_S + (kc * 32 + quad * 8) * 2);
                    O = __builtin_amdgcn_mfma_f32_16x16x32_bf16(sf, qf[qt][kc], O, 0, 0, 0);
                }
                O = __builtin_amdgcn_mfma_f32_16x16x32_bf16(vfi, __builtin_bit_cast(bf16x8, qt ? pw1 : pw0), O, 0, 0, 0);
                *(f32x4*)(OLOC + (rsub + qt * 16 + li) * 512 + h * 128 + wave * 16 + quad * 4) = O;
            }
            const bf16x8 vfa = *(const bf16x8*)(vrow + quad * 16);
#pragma unroll
            for (int dt = 0; dt < 8; ++dt) {
                const bf16x8 k2f = *(const bf16x8*)(KT2 + (dt * 16 + li) * HG_S2 + quad * 16);
                const float ee = Eend[dt * 16 + li];
                SA[dt] = __builtin_amdgcn_mfma_f32_16x16x32_bf16(vfa, k2f, SA[dt] * ee, 0, 0, 0);
            }
            asm volatile("s_waitcnt lgkmcnt(0)" ::: "memory");
#pragma unroll
            for (int dt = 0; dt < 8; ++dt)
#pragma unroll
                for (int j = 0; j < 4; ++j) *(bf16_t*)(SWw + (quad * 4 + j) * MB_S + (dt * 16 + li) * 2) = f2bf(SA[dt][j]);
            asm volatile("s_waitcnt lgkmcnt(0)" ::: "memory");
        }
#pragma unroll
        for (int dt = 0; dt < 8; ++dt)
#pragma unroll
            for (int j = 0; j < 4; ++j) ST[(size_t)w * 16384 + (wave * 16 + quad * 4 + j) * 128 + dt * 16 + li] = SA[dt][j];
        if (tg == 0) DEC[w * 128 + d] = __expf(Bstart);
    }
}

__device__ __forceinline__ void phase_final(const Params& P) {
    const float* SS = (const float*)(P.ws + OFF_SS);
    const int wave = ltid() >> 6, lane = ltid() & 63;
    const f32x4* gr = (const f32x4*)P.final_norm;
    f32x4 g[4];
#pragma unroll
    for (int i = 0; i < 4; ++i) g[i] = gr[lane + 64 * i];
    for (int row = (blockIdx.x * 8 + wave) * 2; row < M_; row += gridDim.x * 16) {
        const float rs0 = row_rstd(SS, row), rs1 = row_rstd(SS, row + 1);
        f32x4* x0 = (f32x4*)(P.out + (size_t)row * D_); f32x4* x1 = x0 + D_ / 4;
        f32x4 v0[4], v1[4];
#pragma unroll
        for (int i = 0; i < 4; ++i) { v0[i] = x0[lane + 64 * i]; v1[i] = x1[lane + 64 * i]; }
#pragma unroll
        for (int i = 0; i < 4; ++i) { x0[lane + 64 * i] = v0[i] * rs0 * g[i]; x1[lane + 64 * i] = v1[i] * rs1 * g[i]; }
    }
}

#define XB_TMO      128
#define XB_XCNT(j)  (256  + 64 * (j))
#define XB_XSUB(j)  (1280 + 64 * (j))
#define XB_XGEN(j)  (2304 + 64 * (j))
#define XB_TOP      3328
#define XB_TOPGEN   3392
#define XCD_BAR_WORDS 3456
#define XB_SPIN_CAP (1u << 18)
__device__ __forceinline__ unsigned xb_ld(unsigned* p)              { return __hip_atomic_load(p, __ATOMIC_RELAXED, __HIP_MEMORY_SCOPE_AGENT); }
__device__ __forceinline__ unsigned xb_add(unsigned* p, unsigned v) { return __hip_atomic_fetch_add(p, v, __ATOMIC_RELAXED, __HIP_MEMORY_SCOPE_AGENT); }
__device__ __forceinline__ unsigned xb_xcc_id() { return (unsigned)__builtin_amdgcn_s_getreg((3 << 11) | 20) & 0xFu; }
#define XB_SPIN(cond, bar) do { unsigned _sp = 0; while (cond) { __builtin_amdgcn_s_sleep(1); \
    if ((++_sp & 255u) == 0u) { if (xb_ld(&(bar)[XB_TMO])) break; if (_sp > XB_SPIN_CAP) { atomicAdd(&(bar)[XB_TMO], 1u); break; } } } } while (0)
struct XcdBarrier { unsigned* bar; unsigned x; volatile LAS unsigned* st; };
__device__ __forceinline__ XcdBarrier xcd_barrier_post(unsigned* bar, volatile LAS unsigned* st) {
    XcdBarrier b; b.bar = bar; b.x = xb_xcc_id(); b.st = st;
    if (threadIdx.x == 0) (void)xb_add(&bar[XB_XCNT(b.x)], 1u);
    return b;
}
__device__ __forceinline__ void xcd_barrier_complete(unsigned* bar, unsigned x, unsigned& nloc, unsigned& nx) {
    const unsigned G = gridDim.x * gridDim.y * gridDim.z;
    unsigned sum, cnt, mine, sp = 0u;
    for (;;) {
        sum = 0u; cnt = 0u; mine = 0u;
#pragma unroll
        for (unsigned j = 0; j < 16; ++j) { const unsigned c = xb_ld(&bar[XB_XCNT(j)]); sum += c; cnt += (c > 0u) ? 1u : 0u; mine = (j == x) ? c : mine; }
        if (sum == G) break;
        __builtin_amdgcn_s_sleep(1);
        if ((++sp & 255u) == 0u) { if (xb_ld(&bar[XB_TMO])) break; if (sp > XB_SPIN_CAP) { atomicAdd(&bar[XB_TMO], 1u); break; } }
    }
    nloc = mine > 0u ? mine : 1u; nx = cnt > 0u ? cnt : 1u;
}
__device__ __forceinline__ void xcd_barrier(const XcdBarrier& b) {
    asm volatile("s_waitcnt vmcnt(0)" ::: "memory");
    __syncthreads();
    if (threadIdx.x == 0) {
        unsigned* bar = b.bar;
        __builtin_amdgcn_s_waitcnt(0);
        unsigned nloc = b.st[0], nx = b.st[1];
        if (nloc == 0u) { xcd_barrier_complete(bar, b.x, nloc, nx); b.st[0] = nloc; b.st[1] = nx; }
        const unsigned old = xb_add(&bar[XB_XSUB(b.x)], 1u);
        const unsigned gen = old / nloc;
        if (old + 1u == (gen + 1u) * nloc) {
            __builtin_amdgcn_fence(__ATOMIC_RELEASE, "agent");
            asm volatile("s_waitcnt vmcnt(0)" ::: "memory");
            const unsigned og = xb_add(&bar[XB_TOP], 1u);
            const unsigned tg = og / nx;
            if (og + 1u == (tg + 1u) * nx) xb_add(&bar[XB_TOPGEN], 1u);
            else XB_SPIN(xb_ld(&bar[XB_TOPGEN]) == tg, bar);
            __builtin_amdgcn_fence(__ATOMIC_ACQUIRE, "agent");
            xb_add(&bar[XB_XGEN(b.x)], 1u);
            asm volatile("s_waitcnt vmcnt(0)" ::: "memory");
        } else {
            XB_SPIN(xb_ld(&bar[XB_XGEN(b.x)]) == gen, bar);
            __builtin_amdgcn_fence(__ATOMIC_ACQUIRE, "agent");
            asm volatile("s_waitcnt vmcnt(0)" ::: "memory");
        }
    }
    __syncthreads();
}

constexpr int N_PHASES = 20;
__global__ void __launch_bounds__(512, 2) mk_fwd(Params P0_, int ph_lo, int ph_hi) {
    extern __shared__ __attribute__((aligned(16))) unsigned char smem[];
    LAS unsigned char* lds = (LAS unsigned char*)smem;
    float* L = (float*)smem;
    XcdBarrier xbar; xbar.bar = (unsigned*)(P0_.ws + OFF_BAR); xbar.x = 0; xbar.st = (volatile LAS unsigned*)(lds + LDS_MISC_OFF);
    if (ph_hi - ph_lo > 1) {
        if (threadIdx.x < 2) xbar.st[threadIdx.x] = 0u;
        if (blockIdx.x == 0) { u32x4* bw = (u32x4*)(P0_.ws + OFF_BAR); for (int i = threadIdx.x; i < 16384 / 16; i += 512) bw[i] = (u32x4){0u, 0u, 0u, 0u}; }
        __syncthreads();
    }
    for (int ph = ph_lo; ph < ph_hi; ++ph) {
        Params P = P0_;
        { size_t z_ = 0; asm volatile("" : "+s"(z_));
#define LAUNDER(f) P.f = P0_.f + z_
        LAUNDER(x); LAUNDER(ffn_norm); LAUNDER(ffn_w_in); LAUNDER(ffn_w_out); LAUNDER(mix_norm); LAUNDER(ab_w_in); LAUNDER(ab_w_out); LAUNDER(lb_logits); LAUNDER(hg_norm);
        LAUNDER(conv_w); LAUNDER(conv_b); LAUNDER(cd_w_in); LAUNDER(cd_w_out); LAUNDER(gate_bias); LAUNDER(ml_norm); LAUNDER(final_norm); LAUNDER(out); LAUNDER(ws);
#undef LAUNDER
        }
        unsigned char* ws = P.ws;
        bf16_t* XB = (bf16_t*)(ws + OFF_XB); float* SS = (float*)(ws + OFF_SS); bf16_t* HP = (bf16_t*)(ws + OFF_HP); bf16_t* Y = (bf16_t*)(ws + OFF_Y);
        int kind = -1, widx = 0;
        switch (ph) {
            case 1: kind = 0; widx = 0; break;  case 2: kind = 1; widx = 0; break;
            case 3: kind = 2; widx = 0; break;  case 7: kind = 3; widx = 0; break;
            case 8: kind = 0; widx = 1; break;  case 9: kind = 1; widx = 1; break;
            case 10: kind = 0; widx = 2; break; case 11: kind = 1; widx = 2; break;
            case 12: kind = 2; widx = 1; break; case 16: kind = 3; widx = 1; break;
            case 17: kind = 0; widx = 3; break; case 18: kind = 1; widx = 3; break;
            default: break;
        }
        if (kind == 0) {
            EpiSwiglu E{HP, (const float*)(ws + OFF_RS)};
            run_gemm<EpiSwiglu>(lds, XB, (const bf16_t*)(ws + OFF_W1T + widx * SZ_W1T), NFF1, D_, E, SS, (float*)(ws + OFF_RS), P, smem, ph == 1 ? 1 : (ph == 8 ? 3 : (ph == 10 ? 4 : 0)));
        } else if (kind == 1 || kind == 3) {
            const float* xin = (ph == 2) ? P.x : P.out;
            EpiResid E{xin, P.out, XB, SS, kind == 1 ? 0.5f : 1.0f, ph == 18 ? 0 : 1};
            const bf16_t* A = (kind == 1) ? HP : Y;
            const bf16_t* Bt = (kind == 1) ? (const bf16_t*)(ws + OFF_W2T + widx * SZ_W2T) : (const bf16_t*)(ws + (widx == 0 ? OFF_ABOUT : OFF_CDOUT));
            run_gemm<EpiResid>(lds, A, Bt, D_, kind == 1 ? FF_ : D_, E, nullptr, nullptr, P, smem, 0);
        } else if (kind == 2) {
            EpiProj E{HP, widx == 0 ? NAB : NCD, (const float*)(ws + OFF_RS), widx == 0 ? nullptr : (float*)(ws + OFF_GATES), 3584};
            run_gemm<EpiProj>(lds, XB, (const bf16_t*)(ws + (widx == 0 ? OFF_ABIN : OFF_CDIN)), widx == 0 ? NAB : NCD, D_, E, SS, (float*)(ws + OFF_RS), P, smem, widx == 0 ? 2 : 0);
        } else {
            switch (ph) {
                case 0: phase_prologue(P, L); break;
                case 4: phase_hgrn_A2(P, smem); break;
                case 5: phase_scan((float*)(ws + OFF_ST), (const float*)(ws + OFF_DEC), 1); phase_conv(P); break;
                case 6: phase_lin_C2<true>(P, smem); break;
                case 13: phase_moba_pre(P, L); phase_mlstm_A2(P, smem); break;
                case 14: phase_scan((float*)(ws + OFF_ST), (const float*)(ws + OFF_DSEG), 0); phase_scan_n((float*)(ws + OFF_NS), (const float*)(ws + OFF_DSEG)); __syncthreads(); phase_moba_attn_mfma(P, smem); break;
                case 15: phase_lin_C2<false>(P, smem); break;
                case 19: phase_final(P); break;
                default: break;
            }
        }
        if (ph + 1 < ph_hi) {
            if (ph == 0) { cg::this_grid().sync(); xbar = xcd_barrier_post((unsigned*)(P0_.ws + OFF_BAR), (volatile LAS unsigned*)(lds + LDS_MISC_OFF)); }
            else xcd_barrier(xbar);
        }
    }
}

extern "C" void kernel_launch(void* const* d_in, const int* in_sizes, int n_in, void* d_out, int out_size, void* d_ws, size_t ws_size, hipStream_t stream) {
    static int grid = 0;
    constexpr int LDS_BYTES = LDS_TOTAL;
    if (grid == 0) {
        if (n_in != 16 || in_sizes[0] != M_ * D_ || out_size != M_ * D_ || ws_size < WS_END) { fprintf(stderr, "kernel_launch: unexpected shapes/workspace (n_in %d, ws %zu, need %zu)\n", n_in, ws_size, (size_t)WS_END); grid = -1; return; }
        int dev = 0, cus = 0, per_cu = 0;
        hipGetDevice(&dev); hipDeviceGetAttribute(&cus, hipDeviceAttributeMultiprocessorCount, dev);
        if (hipFuncSetAttribute((const void*)mk_fwd, hipFuncAttributeMaxDynamicSharedMemorySize, LDS_BYTES) != hipSuccess) { fprintf(stderr, "kernel_launch: hipFuncSetAttribute failed\n"); grid = -1; return; }
        if (hipOccupancyMaxActiveBlocksPerMultiprocessor(&per_cu, (const void*)mk_fwd, 512, LDS_BYTES) != hipSuccess || per_cu < 1) { fprintf(stderr, "kernel_launch: occupancy query failed (%d)\n", per_cu); per_cu = 1; }
        (void)hipGetLastError();
        grid = cus * (per_cu > 1 ? 1 : per_cu);
    }
    if (grid < 0) return;
    Params p{};
    p.x = (const float*)d_in[0]; p.ffn_norm = (const float*)d_in[1]; p.ffn_w_in = (const float*)d_in[2]; p.ffn_w_out = (const float*)d_in[3]; p.mix_norm = (const float*)d_in[4];
    p.ab_w_in = (const float*)d_in[5]; p.ab_w_out = (const float*)d_in[6]; p.lb_logits = (const float*)d_in[7]; p.hg_norm = (const float*)d_in[8]; p.conv_w = (const float*)d_in[9]; p.conv_b = (const float*)d_in[10];
    p.cd_w_in = (const float*)d_in[11]; p.cd_w_out = (const float*)d_in[12]; p.gate_bias = (const float*)d_in[13]; p.ml_norm = (const float*)d_in[14]; p.final_norm = (const float*)d_in[15];
    p.out = (float*)d_out; p.ws = (unsigned char*)d_ws;
#if N_LAUNCH_MODE == 1
    int lo = 0, hi = N_PHASES;
    void* args[] = {&p, &lo, &hi};
    hipError_t e = hipLaunchCooperativeKernel((const void*)mk_fwd, dim3(grid), dim3(512), args, LDS_BYTES, stream);
    if (e != hipSuccess) fprintf(stderr, "cooperative launch failed: %s (grid %d)\n", hipGetErrorString(e), grid);
#else
    for (int ph = 0; ph < N_PHASES; ++ph) {
        hipLaunchKernelGGL(mk_fwd, dim3(grid), dim3(512), LDS_BYTES, stream, p, ph, ph + 1);
    }
#endif
}
```
